# Optimizing an MI355X kernel written in HIP

```python
import math
import jax, jax.numpy as jnp
from jax import lax
import numpy as np

D_MODEL = 1024
BATCH = 16
SEQ = 2048
DEPTH = 1

D_FF = 2816
CHUNK = 128
D_A = 512
SGU_GROUPS = 4
SGU_GROUP_DIM = D_A // SGU_GROUPS
HEAD_DIM = 64
N_Q_HEADS = 8
N_KV_HEADS = 2
Q_PER_KV = N_Q_HEADS // N_KV_HEADS
WINDOW = 128
BLOCK = 128
D_B = N_Q_HEADS * HEAD_DIM
SPLITS = (D_A, D_A, D_B, N_KV_HEADS * HEAD_DIM, N_KV_HEADS * HEAD_DIM, D_MODEL, D_MODEL)
IN_COLS = sum(SPLITS)
N_MOD = 9
EPS = 1e-6
NEG = -1e30

kernel_name = "hybrid_gmlp_swa_sink_macaron_adaln"


def rms_norm(x, g):
    xf = x.astype(jnp.float32)
    y = xf * lax.rsqrt(jnp.mean(xf * xf, axis=-1, keepdims=True) + EPS)
    return (y * g.astype(jnp.float32)).astype(x.dtype)


def layer_norm(x, g, b):
    xf = x.astype(jnp.float32)
    mu = jnp.mean(xf, axis=-1, keepdims=True)
    var = jnp.mean(jnp.square(xf - mu), axis=-1, keepdims=True)
    y = (xf - mu) * lax.rsqrt(var + EPS)
    return (y * g.astype(jnp.float32) + b.astype(jnp.float32)).astype(x.dtype)


def modulate(xn, shift, scale):
    return xn * (1 + scale[:, None, :]) + shift[:, None, :]


def swiglu(x, w_gate, w_up, w_down):
    return (jax.nn.silu(x @ w_gate) * (x @ w_up)) @ w_down


def gmlp_sgu(u, v, g_ln, b_ln, w_s, b_s):
    bsz, seq, _ = v.shape
    n_chunks = seq // CHUNK
    v = layer_norm(v, g_ln, b_ln)
    vg = v.reshape(bsz, n_chunks, CHUNK, SGU_GROUPS, SGU_GROUP_DIM)
    causal = jnp.tril(jnp.ones((CHUNK, CHUNK), dtype=bool))
    ws = jnp.where(causal[None], w_s, jnp.zeros_like(w_s))
    z = jnp.einsum('gts,bnsgc->bntgc', ws, vg)
    z = z + b_s.T[None, None, :, :, None]
    return u * z.reshape(bsz, seq, D_A)


def sliding_window_attention(q, k, v, g_q, g_k, sinks):
    bsz, seq = q.shape[0], q.shape[1]
    nb = seq // BLOCK
    q = rms_norm(q, g_q)
    k = rms_norm(k, g_k)
    pad = ((0, 0), (BLOCK, 0), (0, 0), (0, 0))
    k_prev = jnp.pad(k, pad)[:, :seq]
    v_prev = jnp.pad(v, pad)[:, :seq]
    kb = jnp.concatenate([k_prev.reshape(bsz, nb, BLOCK, N_KV_HEADS, HEAD_DIM),
                          k.reshape(bsz, nb, BLOCK, N_KV_HEADS, HEAD_DIM)], axis=2)
    vb = jnp.concatenate([v_prev.reshape(bsz, nb, BLOCK, N_KV_HEADS, HEAD_DIM),
                          v.reshape(bsz, nb, BLOCK, N_KV_HEADS, HEAD_DIM)], axis=2)
    qb = q.reshape(bsz, nb, BLOCK, N_KV_HEADS, Q_PER_KV, HEAD_DIM)
    scores = jnp.einsum('bnqhgd,bnkhd->bnhgqk', qb, kb).astype(jnp.float32)
    scores = scores * (HEAD_DIM ** -0.5)
    blk = jnp.arange(nb)[:, None, None]
    qpos = blk * BLOCK + jnp.arange(BLOCK)[None, :, None]
    kpos = (blk - 1) * BLOCK + jnp.arange(2 * BLOCK)[None, None, :]
    diff = qpos - kpos
    valid = (diff >= 0) & (diff < WINDOW) & (kpos >= 0)
    scores = jnp.where(valid[None, :, None, None], scores, NEG)
    sink = jnp.broadcast_to(
        sinks.astype(jnp.float32).reshape(1, 1, N_KV_HEADS, Q_PER_KV, 1, 1),
        scores.shape[:-1] + (1,))
    probs = jax.nn.softmax(jnp.concatenate([scores, sink], axis=-1), axis=-1)[..., :-1]
    out = jnp.einsum('bnhgqk,bnkhd->bnqhgd', probs.astype(v.dtype), vb)
    return out.reshape(bsz, seq, D_B)


def setup_inputs(seed: int = 0) -> dict:
    key = jax.random.key(seed)
    ks = jax.random.split(key, 26)
    f32 = jnp.float32
    L = DEPTH

    def nrm(k, shape, fan_in):
        return jax.random.normal(k, shape, f32) * (fan_in ** -0.5)

    def gain(k, shape):
        return 1.0 + 0.02 * jax.random.normal(k, shape, f32)

    return {
        "x": jax.random.normal(ks[0], (BATCH, SEQ, D_MODEL), f32),
        "c": jax.random.normal(ks[1], (BATCH, D_MODEL), f32),
        "w_ada": nrm(ks[2], (L, D_MODEL, N_MOD * D_MODEL), D_MODEL) * 0.5,
        "b_ada": 0.01 * jax.random.normal(ks[3], (L, N_MOD * D_MODEL), f32),
        "g_norm1": gain(ks[4], (L, D_MODEL)),
        "ffn1_w_gate": nrm(ks[5], (L, D_MODEL, D_FF), D_MODEL),
        "ffn1_w_up": nrm(ks[6], (L, D_MODEL, D_FF), D_MODEL),
        "ffn1_w_down": nrm(ks[7], (L, D_FF, D_MODEL), D_FF),
        "g_norm2": gain(ks[8], (L, D_MODEL)),
        "w_in": nrm(ks[9], (L, D_MODEL, IN_COLS), D_MODEL),
        "g_sgu_ln": gain(ks[10], (L, D_A)),
        "b_sgu_ln": 0.01 * jax.random.normal(ks[11], (L, D_A), f32),
        "w_spatial": nrm(ks[12], (L, SGU_GROUPS, CHUNK, CHUNK), CHUNK),
        "b_spatial": 1.0 + 0.02 * jax.random.normal(ks[13], (L, SGU_GROUPS, CHUNK), f32),
        "g_q": gain(ks[14], (L, HEAD_DIM)),
        "g_k": gain(ks[15], (L, HEAD_DIM)),
        "attn_sinks": jax.random.normal(ks[16], (L, N_Q_HEADS), f32),
        "w_branch_a": nrm(ks[17], (L, D_A, D_MODEL), D_A),
        "w_branch_b": nrm(ks[18], (L, D_B, D_MODEL), D_B),
        "w_out": nrm(ks[19], (L, D_MODEL, D_MODEL), D_MODEL),
        "g_norm3": gain(ks[20], (L, D_MODEL)),
        "ffn2_w_gate": nrm(ks[21], (L, D_MODEL, D_FF), D_MODEL),
        "ffn2_w_up": nrm(ks[22], (L, D_MODEL, D_FF), D_MODEL),
        "ffn2_w_down": nrm(ks[23], (L, D_FF, D_MODEL), D_FF),
    }


def reference(x, c, w_ada, b_ada, g_norm1, ffn1_w_gate, ffn1_w_up, ffn1_w_down,
              g_norm2, w_in, g_sgu_ln, b_sgu_ln, w_spatial, b_spatial, g_q, g_k,
              attn_sinks, w_branch_a, w_branch_b, w_out, g_norm3,
              ffn2_w_gate, ffn2_w_up, ffn2_w_down):
    bsz, seq, _ = x.shape
    cond = jax.nn.silu(c)
    split_idx = list(np.cumsum(SPLITS)[:-1])
    h = x
    for l in range(DEPTH):
        mods = cond @ w_ada[l] + b_ada[l]
        sh1, sc1, ga1, sh2, sc2, ga2, sh3, sc3, ga3 = jnp.split(mods, N_MOD, axis=-1)

        xn = modulate(rms_norm(h, g_norm1[l]), sh1, sc1)
        h = h + 0.5 * ga1[:, None, :] * swiglu(xn, ffn1_w_gate[l], ffn1_w_up[l], ffn1_w_down[l])

        xn = modulate(rms_norm(h, g_norm2[l]), sh2, sc2)
        proj = xn @ w_in[l]
        a_u, a_v, q, k, v, gate_a, gate_b = jnp.split(proj, split_idx, axis=-1)

        y_a = gmlp_sgu(jax.nn.gelu(a_u), jax.nn.gelu(a_v), g_sgu_ln[l], b_sgu_ln[l],
                       w_spatial[l], b_spatial[l]) @ w_branch_a[l]

        y_b = sliding_window_attention(
            q.reshape(bsz, seq, N_Q_HEADS, HEAD_DIM),
            k.reshape(bsz, seq, N_KV_HEADS, HEAD_DIM),
            v.reshape(bsz, seq, N_KV_HEADS, HEAD_DIM),
            g_q[l], g_k[l], attn_sinks[l]) @ w_branch_b[l]

        merged = jax.nn.sigmoid(gate_a) * y_a + jax.nn.sigmoid(gate_b) * y_b
        h = h + ga2[:, None, :] * (merged @ w_out[l])

        xn = modulate(rms_norm(h, g_norm3[l]), sh3, sc3)
        h = h + 0.5 * ga3[:, None, :] * swiglu(xn, ffn2_w_gate[l], ffn2_w_up[l], ffn2_w_down[l])
    return h
```

```cpp
#include <hip/hip_runtime.h>
#include <cstdio>
#include <cstdint>
#include <cstring>

typedef unsigned short bf16_t;
__device__ __forceinline__ float bf2f(bf16_t h) { return __uint_as_float(((unsigned)h) << 16); }
__device__ __forceinline__ bf16_t f2bf(float f) { unsigned u = __float_as_uint(f); return (bf16_t)((u + 0x7fffu + ((u >> 16) & 1u)) >> 16); }

constexpr int BATCH = 16, SEQ = 2048, D = 1024, M = BATCH * SEQ;
constexpr int FF = 2816, NGU = 2 * FF;
constexpr int DA = 512, DB = 512, NIN = 3840, NMOD = 9 * D;
constexpr int CHUNK = 128, NCH = SEQ / CHUNK, NG = 4, GD = 128;
constexpr int HD = 64, NQH = 8, NKVH = 2;
constexpr int PC_U = 0, PC_V = 512, PC_Q = 1024, PC_K = 1536, PC_VV = 1664, PC_GA = 1792, PC_GB = 2816;
constexpr float EPS = 1e-6f;

constexpr size_t MiB = 1u << 20;
constexpr size_t WS_CTL = 0, CTL_BYTES = 1 * MiB;
constexpr size_t CTL_SS2 = 256 * 1024, CTL_SS3 = 384 * 1024;
constexpr size_t WS_MODS = 1 * MiB;
constexpr size_t WS_GS = WS_MODS + 640 * 1024;
constexpr size_t WS_CB1 = WS_GS + 192 * 1024;
constexpr size_t WS_CB2 = WS_CB1 + 352 * 1024;
constexpr size_t WS_CB3 = WS_CB2 + 240 * 1024;
constexpr size_t WS_SS1 = WS_CB3 + 352 * 1024;
constexpr size_t WS_SMALL_END = WS_SS1 + 128 * 1024;
static_assert(WS_SMALL_END <= 4 * MiB, "small tables");
constexpr size_t WS_WGU1 = 4 * MiB;
constexpr size_t WS_WD1 = WS_WGU1 + (size_t)NGU * D * 2;
constexpr size_t WS_WIN = WS_WD1 + (size_t)D * FF * 2;
constexpr size_t WS_WA = WS_WIN + (size_t)NIN * D * 2;
constexpr size_t WS_WB = WS_WA + (size_t)D * DA * 2;
constexpr size_t WS_WO = WS_WB + (size_t)D * DB * 2;
constexpr size_t WS_WGU2 = WS_WO + (size_t)D * D * 2;
constexpr size_t WS_WD2 = WS_WGU2 + (size_t)NGU * D * 2;
constexpr size_t WS_WSP = WS_WD2 + (size_t)D * FF * 2;
constexpr size_t WS_W_END = WS_WSP + (size_t)NG * CHUNK * CHUNK * 2;
static_assert(WS_W_END <= 50 * MiB, "weights");
constexpr size_t WS_XN = 50 * MiB;
constexpr size_t WS_MIX = 114 * MiB;
constexpr size_t WS_MERGED = 178 * MiB;
constexpr size_t WS_ACT = 242 * MiB;
constexpr size_t WS_P = 242 * MiB;
constexpr size_t WS_END = 482 * MiB;

__device__ __forceinline__ float sigmoidf_(float v) { return 1.0f / (1.0f + __expf(-v)); }
__device__ __forceinline__ float siluf_(float v) { return v * sigmoidf_(v); }
__device__ __forceinline__ float gelu_tanh_(float v) {
    const float u = 0.7978845608028654f * (v + 0.044715f * v * v * v);
    return v * sigmoidf_(2.0f * u);
}

__global__ void k_mods(const float* c, const float* w_ada, const float* b_ada, float* mods) {
    const int j = blockIdx.x * blockDim.x + threadIdx.x, b = blockIdx.y;
    if (j >= NMOD) return;
    float acc = 0.f;
    for (int k = 0; k < D; ++k) acc += siluf_(c[b * D + k]) * w_ada[(size_t)k * NMOD + j];
    mods[b * NMOD + j] = acc + b_ada[j];
}
__global__ void k_wconv(const float* W, int K, int N, bf16_t* WT, int mode) {
    __shared__ float t[32][33];
    const int n0 = blockIdx.x * 32, k0 = blockIdx.y * 32, tx = threadIdx.x, ty = threadIdx.y;
    for (int i = ty; i < 32; i += 8) t[i][tx] = W[(size_t)(k0 + i) * N + n0 + tx];
    __syncthreads();
    for (int i = ty; i < 32; i += 8) {
        const int n = n0 + i; int r = n;
        if (mode) r = 256 * (n >> 7) + (n & 127) + 128 * (mode - 1);
        WT[(size_t)r * K + k0 + tx] = f2bf(t[tx][i]);
    }
}
__global__ void k_wsp(const float* w, bf16_t* o) {
    const int i = blockIdx.x * blockDim.x + threadIdx.x; if (i >= NG * CHUNK * CHUNK) return;
    const int s = i & 127, t = (i >> 7) & 127; o[i] = f2bf(s <= t ? w[i] : 0.f);
}
__global__ void k_gs(const float* mods, const float* g1, const float* g2, const float* g3, float* gs) {
    const int i = blockIdx.x * blockDim.x + threadIdx.x; if (i >= 3 * BATCH * D) return;
    const int k = i & 1023, b = (i >> 10) & 15, which = i >> 14;
    const float* g = which == 0 ? g1 : which == 1 ? g2 : g3;
    gs[i] = g[k] * (1.0f + mods[b * NMOD + (3 * which + 1) * D + k]);
}
__global__ void k_cb(const float* mods, int which, const bf16_t* Wt, int N, float* cb) {
    const int wave = (blockIdx.x * blockDim.x + threadIdx.x) >> 6, lane = threadIdx.x & 63;
    if (wave >= N) return;
    float w[16];
    for (int i = 0; i < 16; ++i) w[i] = bf2f(Wt[(size_t)wave * D + lane * 16 + i]);
    for (int b = 0; b < BATCH; ++b) {
        const float* sh = mods + b * NMOD + 3 * which * D + lane * 16;
        float s = 0.f;
        for (int i = 0; i < 16; ++i) s += sh[i] * w[i];
        for (int o = 1; o < 64; o <<= 1) s += __shfl_xor(s, o);
        if (lane == 0) cb[b * N + wave] = s;
    }
}
__global__ void k_xpass(const float* x, const float* gs, bf16_t* xn, float* ss) {
    const int m = (blockIdx.x * blockDim.x + threadIdx.x) >> 6, lane = threadIdx.x & 63;
    if (m >= M) return;
    const int b = m >> 11; float s = 0.f;
    for (int i = 0; i < 16; ++i) { const int k = i * 64 + lane; const float v = x[(size_t)m * D + k]; s += v * v; xn[(size_t)m * D + k] = f2bf(v * gs[b * D + k]); }
    for (int o = 1; o < 64; o <<= 1) s += __shfl_xor(s, o);
    if (lane == 0) ss[m] = s;
}
__global__ void k_rowss(const float* h, float* ss) {
    const int m = (blockIdx.x * blockDim.x + threadIdx.x) >> 6, lane = threadIdx.x & 63;
    if (m >= M) return;
    float s = 0.f;
    for (int i = 0; i < 16; ++i) { const float v = h[(size_t)m * D + i * 64 + lane]; s += v * v; }
    for (int o = 1; o < 64; o <<= 1) s += __shfl_xor(s, o);
    if (lane == 0) ss[m] = s;
}

template <class E> __global__ __launch_bounds__(256) void k_ngemm(E e, int K) {
    __shared__ float As[16][64 + 4], Bs[16][64 + 4];
    const int tid = threadIdx.x, tx = tid & 15, ty = tid >> 4, m0 = blockIdx.y * 64, n0 = blockIdx.x * 64;
    float acc[E::NACC][4][4];
    for (int w = 0; w < E::NACC; ++w) for (int i = 0; i < 4; ++i) for (int j = 0; j < 4; ++j) acc[w][i][j] = 0.f;
    const int lr = tid >> 2, lk = (tid & 3) * 4;
#pragma unroll
    for (int w = 0; w < E::NACC; ++w) {
        const bf16_t* Ap = e.a_ptr(w) + (size_t)(m0 + lr) * e.lda + lk;
        const bf16_t* Bp = e.b_ptr(w) + (size_t)e.brow(n0 + lr, w) * e.ldb + lk;
        for (int k0 = 0; k0 < K; k0 += 16) {
            const uint2 av = *(const uint2*)(Ap + k0), bv = *(const uint2*)(Bp + k0);
            __syncthreads();
            As[lk + 0][lr] = __uint_as_float(av.x << 16); As[lk + 1][lr] = __uint_as_float(av.x & 0xffff0000u);
            As[lk + 2][lr] = __uint_as_float(av.y << 16); As[lk + 3][lr] = __uint_as_float(av.y & 0xffff0000u);
            Bs[lk + 0][lr] = __uint_as_float(bv.x << 16); Bs[lk + 1][lr] = __uint_as_float(bv.x & 0xffff0000u);
            Bs[lk + 2][lr] = __uint_as_float(bv.y << 16); Bs[lk + 3][lr] = __uint_as_float(bv.y & 0xffff0000u);
            __syncthreads();
#pragma unroll
            for (int k = 0; k < 16; ++k) {
                const float4 a = *(const float4*)&As[k][ty * 4], b = *(const float4*)&Bs[k][tx * 4];
                const float aa[4] = {a.x, a.y, a.z, a.w}, bb[4] = {b.x, b.y, b.z, b.w};
#pragma unroll
                for (int i = 0; i < 4; ++i)
#pragma unroll
                    for (int j = 0; j < 4; ++j) acc[w][i][j] += aa[i] * bb[j];
            }
        }
    }
    for (int i = 0; i < 4; ++i) for (int j = 0; j < 4; ++j) {
        float a2[2]; a2[0] = acc[0][i][j]; a2[1] = E::NACC > 1 ? acc[E::NACC - 1][i][j] : 0.f;
        e.store(m0 + ty * 4 + i, n0 + tx * 4 + j, a2);
    }
}
__device__ __forceinline__ float rstd_of(const float* ss, int m) { return rsqrtf(ss[m] * (1.0f / D) + EPS); }

struct NE_gu {
    static constexpr int NACC = 2;
    const bf16_t* A; const bf16_t* W; const float* ss; const float* cb; bf16_t* act; int lda, ldb;
    __device__ const bf16_t* a_ptr(int) const { return A; }
    __device__ const bf16_t* b_ptr(int) const { return W; }
    __device__ int brow(int n, int w) const { return 256 * (n >> 7) + (n & 127) + 128 * w; }
    __device__ void store(int m, int n, const float* a) const {
        const int b = m >> 11, r0 = brow(n, 0); const float rs = rstd_of(ss, m);
        const float g = a[0] * rs + cb[b * NGU + r0], u = a[1] * rs + cb[b * NGU + r0 + 128];
        act[(size_t)m * FF + n] = f2bf(siluf_(g) * u);
    }
};
struct NE_res {
    static constexpr int NACC = 1;
    const bf16_t* A; const bf16_t* W; int lda, ldb; const float* resid; float* hout; const float* ga; float gscale; const float* gs; bf16_t* xn;
    __device__ const bf16_t* a_ptr(int) const { return A; }
    __device__ const bf16_t* b_ptr(int) const { return W; }
    __device__ int brow(int n, int) const { return n; }
    __device__ void store(int m, int n, const float* a) const {
        const int b = m >> 11; const float v = resid[(size_t)m * D + n] + gscale * ga[b * NMOD + n] * a[0];
        hout[(size_t)m * D + n] = v;
        if (xn) xn[(size_t)m * D + n] = f2bf(v * gs[b * D + n]);
    }
};
struct NE_win {
    static constexpr int NACC = 1;
    const bf16_t* A; const bf16_t* W; int lda, ldb; const float* ss; const float* cb; bf16_t* P;
    __device__ const bf16_t* a_ptr(int) const { return A; }
    __device__ const bf16_t* b_ptr(int) const { return W; }
    __device__ int brow(int n, int) const { return n; }
    __device__ void store(int m, int n, const float* a) const {
        const int b = m >> 11; float v = a[0] * rstd_of(ss, m) + cb[b * NIN + n];
        if (n < PC_Q) v = gelu_tanh_(v); else if (n >= PC_GA) v = sigmoidf_(v);
        P[(size_t)m * NIN + n] = f2bf(v);
    }
};
struct NE_branch {
    static constexpr int NACC = 2;
    const bf16_t* MIX; const bf16_t* WA; const bf16_t* WB; int lda, ldb; const bf16_t* P; bf16_t* merged;
    __device__ const bf16_t* a_ptr(int w) const { return MIX + w * 512; }
    __device__ const bf16_t* b_ptr(int w) const { return w ? WB : WA; }
    __device__ int brow(int n, int) const { return n; }
    __device__ void store(int m, int n, const float* a) const {
        const float sga = bf2f(P[(size_t)m * NIN + PC_GA + n]), sgb = bf2f(P[(size_t)m * NIN + PC_GB + n]);
        merged[(size_t)m * D + n] = f2bf(sga * a[0] + sgb * a[1]);
    }
};

__global__ void k_vln(const bf16_t* P, const float* g, const float* bta, bf16_t* vn) {
    const int m = (blockIdx.x * blockDim.x + threadIdx.x) >> 6, lane = threadIdx.x & 63;
    if (m >= M) return;
    float v[8], s = 0.f;
    for (int i = 0; i < 8; ++i) { v[i] = bf2f(P[(size_t)m * NIN + PC_V + i * 64 + lane]); s += v[i]; }
    for (int o = 1; o < 64; o <<= 1) s += __shfl_xor(s, o);
    const float mu = s * (1.0f / DA); float q = 0.f;
    for (int i = 0; i < 8; ++i) { v[i] -= mu; q += v[i] * v[i]; }
    for (int o = 1; o < 64; o <<= 1) q += __shfl_xor(q, o);
    const float rs = rsqrtf(q * (1.0f / DA) + EPS);
    for (int i = 0; i < 8; ++i) { const int c = i * 64 + lane; vn[(size_t)m * DA + c] = f2bf(v[i] * rs * g[c] + bta[c]); }
}
__global__ void k_sgu(const bf16_t* P, const bf16_t* vn, const bf16_t* wsp, const float* bsp, bf16_t* mix) {
    const int ch = threadIdx.x + (blockIdx.x & 1) * 256, m = blockIdx.x >> 1;
    const int t = m & 127, g = ch >> 7, m0 = m - t;
    float z = 0.f;
    for (int s = 0; s <= t; ++s) z += bf2f(wsp[(g * 128 + t) * 128 + s]) * bf2f(vn[(size_t)(m0 + s) * DA + ch]);
    z += bsp[g * 128 + t];
    mix[(size_t)m * D + ch] = f2bf(bf2f(P[(size_t)m * NIN + PC_U + ch]) * z);
}
__global__ __launch_bounds__(128) void k_attn(const bf16_t* P, const float* gq, const float* gk, const float* sinks, bf16_t* mix) {
    const int i = threadIdx.x, hq = blockIdx.x & 7, n = (blockIdx.x >> 3) & 15, b = blockIdx.x >> 7, h = hq >> 2;
    const int m = b * SEQ + n * 128 + i;
    float q[64], o[64]; float s2 = 0.f;
    for (int d = 0; d < 64; ++d) { q[d] = bf2f(P[(size_t)m * NIN + PC_Q + hq * 64 + d]); s2 += q[d] * q[d]; o[d] = 0.f; }
    const float qs = rsqrtf(s2 * (1.0f / 64) + EPS) * 0.125f;
    for (int d = 0; d < 64; ++d) q[d] *= qs * gq[d];
    const float sink = sinks[hq];
    float mx = sink, l = 1.0f;
    for (int dj = 127; dj >= 0; --dj) {
        const int kp = n * 128 + i - dj; if (kp < 0) continue;
        const bf16_t* kr = P + (size_t)(b * SEQ + kp) * NIN + PC_K + h * 64;
        float kk[64], k2 = 0.f;
        for (int d = 0; d < 64; ++d) { kk[d] = bf2f(kr[d]); k2 += kk[d] * kk[d]; }
        const float ks = rsqrtf(k2 * (1.0f / 64) + EPS); float sc = 0.f;
        for (int d = 0; d < 64; ++d) sc += q[d] * kk[d] * gk[d];
        sc *= ks;
        const float nm = fmaxf(mx, sc), f = __expf(mx - nm), p = __expf(sc - nm);
        const bf16_t* vr = P + (size_t)(b * SEQ + kp) * NIN + PC_VV + h * 64;
        for (int d = 0; d < 64; ++d) o[d] = o[d] * f + p * bf2f(vr[d]);
        l = l * f + p; mx = nm;
    }
    const float il = 1.0f / l;
    for (int d = 0; d < 64; ++d) mix[(size_t)m * D + 512 + hq * 64 + d] = f2bf(o[d] * il);
}

extern "C" void kernel_launch(void* const* d_in, const int* in_sizes, int n_in, void* d_out, int out_size, void* d_ws, size_t ws_size, hipStream_t stream) {
    if (n_in != 24 || in_sizes[0] != M * D || out_size != M * D || ws_size < WS_END) {
        fprintf(stderr, "kernel_launch: unexpected shapes (n_in %d, in0 %d, out %d, ws %zu < %zu)\n", n_in, n_in > 0 ? in_sizes[0] : -1, out_size, ws_size, (size_t)WS_END);
        return;
    }
    const float* const* in = (const float* const*)d_in;
    unsigned char* ws = (unsigned char*)d_ws; float* out = (float*)d_out;
    float* mods = (float*)(ws + WS_MODS); float* gs = (float*)(ws + WS_GS);
    float* cb1 = (float*)(ws + WS_CB1); float* cb2 = (float*)(ws + WS_CB2); float* cb3 = (float*)(ws + WS_CB3);
    float* ss1 = (float*)(ws + WS_SS1); float* ss2 = (float*)(ws + WS_CTL + CTL_SS2); float* ss3 = (float*)(ws + WS_CTL + CTL_SS3);
    bf16_t* WGU1 = (bf16_t*)(ws + WS_WGU1); bf16_t* WD1 = (bf16_t*)(ws + WS_WD1); bf16_t* WIN = (bf16_t*)(ws + WS_WIN);
    bf16_t* WA = (bf16_t*)(ws + WS_WA); bf16_t* WB = (bf16_t*)(ws + WS_WB); bf16_t* WO = (bf16_t*)(ws + WS_WO);
    bf16_t* WGU2 = (bf16_t*)(ws + WS_WGU2); bf16_t* WD2 = (bf16_t*)(ws + WS_WD2); bf16_t* WSP = (bf16_t*)(ws + WS_WSP);
    bf16_t* XN = (bf16_t*)(ws + WS_XN); bf16_t* MIX = (bf16_t*)(ws + WS_MIX); bf16_t* MERGED = (bf16_t*)(ws + WS_MERGED);
    bf16_t* ACT = (bf16_t*)(ws + WS_ACT); bf16_t* P = (bf16_t*)(ws + WS_P);
    bf16_t* VN = MERGED;

    (void)hipMemsetAsync(ws + WS_CTL, 0, CTL_BYTES, stream);
    k_mods<<<dim3(NMOD / 256, BATCH), 256, 0, stream>>>(in[1], in[2], in[3], mods);
    const dim3 tb(32, 8);
    k_wconv<<<dim3(FF / 32, D / 32), tb, 0, stream>>>(in[5], D, FF, WGU1, 1);
    k_wconv<<<dim3(FF / 32, D / 32), tb, 0, stream>>>(in[6], D, FF, WGU1, 2);
    k_wconv<<<dim3(D / 32, FF / 32), tb, 0, stream>>>(in[7], FF, D, WD1, 0);
    k_wconv<<<dim3(NIN / 32, D / 32), tb, 0, stream>>>(in[9], D, NIN, WIN, 0);
    k_wconv<<<dim3(D / 32, DA / 32), tb, 0, stream>>>(in[17], DA, D, WA, 0);
    k_wconv<<<dim3(D / 32, DB / 32), tb, 0, stream>>>(in[18], DB, D, WB, 0);
    k_wconv<<<dim3(D / 32, D / 32), tb, 0, stream>>>(in[19], D, D, WO, 0);
    k_wconv<<<dim3(FF / 32, D / 32), tb, 0, stream>>>(in[21], D, FF, WGU2, 1);
    k_wconv<<<dim3(FF / 32, D / 32), tb, 0, stream>>>(in[22], D, FF, WGU2, 2);
    k_wconv<<<dim3(D / 32, FF / 32), tb, 0, stream>>>(in[23], FF, D, WD2, 0);
    k_wsp<<<NG * CHUNK * CHUNK / 256, 256, 0, stream>>>(in[12], WSP);
    k_gs<<<3 * BATCH * D / 256, 256, 0, stream>>>(mods, in[4], in[8], in[20], gs);
    k_cb<<<NGU / 4, 256, 0, stream>>>(mods, 0, WGU1, NGU, cb1);
    k_cb<<<NIN / 4, 256, 0, stream>>>(mods, 1, WIN, NIN, cb2);
    k_cb<<<NGU / 4, 256, 0, stream>>>(mods, 2, WGU2, NGU, cb3);
    k_xpass<<<M / 4, 256, 0, stream>>>(in[0], gs, XN, ss1);
    { NE_gu e; memset(&e, 0, sizeof e); e.A = XN; e.W = WGU1; e.ss = ss1; e.cb = cb1; e.act = ACT; e.lda = D; e.ldb = D; k_ngemm<NE_gu><<<dim3(FF / 64, M / 64), 256, 0, stream>>>(e, D); }
    { NE_res e; memset(&e, 0, sizeof e); e.A = ACT; e.W = WD1; e.lda = FF; e.ldb = FF; e.resid = in[0]; e.hout = out; e.ga = mods + 2 * D; e.gscale = 0.5f; e.gs = gs + 1 * BATCH * D; e.xn = XN; k_ngemm<NE_res><<<dim3(D / 64, M / 64), 256, 0, stream>>>(e, FF); }
    k_rowss<<<M / 4, 256, 0, stream>>>(out, ss2);
    { NE_win e; memset(&e, 0, sizeof e); e.A = XN; e.W = WIN; e.lda = D; e.ldb = D; e.ss = ss2; e.cb = cb2; e.P = P; k_ngemm<NE_win><<<dim3(NIN / 64, M / 64), 256, 0, stream>>>(e, D); }
    k_vln<<<M / 4, 256, 0, stream>>>(P, in[10], in[11], VN);
    k_sgu<<<M * 2, 256, 0, stream>>>(P, VN, WSP, in[13], MIX);
    k_attn<<<BATCH * NCH * NQH, 128, 0, stream>>>(P, in[14], in[15], in[16], MIX);
    { NE_branch e; memset(&e, 0, sizeof e); e.MIX = MIX; e.WA = WA; e.WB = WB; e.lda = D; e.ldb = DA; e.P = P; e.merged = MERGED; k_ngemm<NE_branch><<<dim3(D / 64, M / 64), 256, 0, stream>>>(e, DA); }
    { NE_res e; memset(&e, 0, sizeof e); e.A = MERGED; e.W = WO; e.lda = D; e.ldb = D; e.resid = out; e.hout = out; e.ga = mods + 5 * D; e.gscale = 1.0f; e.gs = gs + 2 * BATCH * D; e.xn = XN; k_ngemm<NE_res><<<dim3(D / 64, M / 64), 256, 0, stream>>>(e, D); }
    k_rowss<<<M / 4, 256, 0, stream>>>(out, ss3);
    { NE_gu e; memset(&e, 0, sizeof e); e.A = XN; e.W = WGU2; e.ss = ss3; e.cb = cb3; e.act = ACT; e.lda = D; e.ldb = D; k_ngemm<NE_gu><<<dim3(FF / 64, M / 64), 256, 0, stream>>>(e, D); }
    { NE_res e; memset(&e, 0, sizeof e); e.A = ACT; e.W = WD2; e.lda = FF; e.ldb = FF; e.resid = out; e.hout = out; e.ga = mods + 8 * D; e.gscale = 0.5f; k_ngemm<NE_res><<<dim3(D / 64, M / 64), 256, 0, stream>>>(e, FF); }
}
```

```cpp
#include <hip/hip_runtime.h>
#include <cstdio>
#include <cstdint>
#include <cstring>
#ifndef N_LAUNCHES
#define N_LAUNCHES 2
#endif

typedef unsigned short bf16_t;
typedef short bf16x8 __attribute__((ext_vector_type(8)));
typedef float f32x4 __attribute__((ext_vector_type(4)));
typedef float f32x2 __attribute__((ext_vector_type(2)));
typedef unsigned u32x4 __attribute__((ext_vector_type(4)));
typedef unsigned u32x2 __attribute__((ext_vector_type(2)));
#define GAS __attribute__((address_space(1)))
#define LAS __attribute__((address_space(3)))
#define RLX_AGENT __ATOMIC_RELAXED, __HIP_MEMORY_SCOPE_AGENT
#define LDS_WAIT() asm volatile("s_waitcnt lgkmcnt(0)" ::: "memory")
#define VM_WAIT() asm volatile("s_waitcnt vmcnt(0)" ::: "memory")

__device__ __forceinline__ float bf2f(bf16_t h) { return __uint_as_float(((unsigned)h) << 16); }
__device__ __forceinline__ unsigned f2bf(float f) { unsigned u = __float_as_uint(f); return (u + 0x7fffu + ((u >> 16) & 1u)) >> 16; }
__device__ __forceinline__ unsigned pk2(float lo, float hi) { return f2bf(lo) | (f2bf(hi) << 16); }
__device__ __forceinline__ unsigned cvt_pk_bf16(float lo, float hi) { unsigned r; asm volatile("v_cvt_pk_bf16_f32 %0, %1, %2" : "=v"(r) : "v"(lo), "v"(hi)); return r; }
__device__ __forceinline__ float bflo(unsigned w) { return __uint_as_float(w << 16); }
__device__ __forceinline__ float bfhi(unsigned w) { return __uint_as_float(w & 0xffff0000u); }

constexpr int BATCH = 16, SEQ = 2048, D = 1024, M = BATCH * SEQ;
constexpr int FF = 2816, NGU = 2 * FF;
constexpr int DA = 512, DB = 512, NIN = 3840, NMOD = 9 * D;
constexpr int CHUNK = 128, NCH = SEQ / CHUNK, NG = 4, GD = 128;
constexpr int HD = 64, NQH = 8, NKVH = 2;
constexpr int PC_U = 0, PC_V = 512, PC_Q = 1024, PC_K = 1536, PC_VV = 1664, PC_GA = 1792, PC_GB = 2816;
constexpr float EPS = 1e-6f;
constexpr float LOG2E = 1.4426950408889634f;

constexpr size_t MiB = 1u << 20;
constexpr size_t WS_CTL = 0, CTL_BYTES = 1 * MiB;
constexpr int CW_BAR = 4096;
constexpr size_t CTL_SS2 = 256 * 1024, CTL_SS3 = 384 * 1024;
constexpr size_t WS_MODS = 1 * MiB;
constexpr size_t WS_CB1 = WS_MODS + 640 * 1024;
constexpr size_t WS_CB2 = WS_CB1 + 352 * 1024;
constexpr size_t WS_CB3 = WS_CB2 + 240 * 1024;
constexpr size_t WS_SS1 = WS_CB3 + 352 * 1024;
constexpr size_t WS_SMALL_END = WS_SS1 + 128 * 1024;
static_assert(WS_SMALL_END <= 4 * MiB, "small tables");
constexpr size_t WS_WGU1 = 4 * MiB;
constexpr size_t WS_WD1 = WS_WGU1 + (size_t)NGU * D * 2;
constexpr size_t WS_WIN = WS_WD1 + (size_t)D * FF * 2;
constexpr size_t WS_WA = WS_WIN + (size_t)NIN * D * 2;
constexpr size_t WS_WB = WS_WA + (size_t)D * DA * 2;
constexpr size_t WS_WO = WS_WB + (size_t)D * DB * 2;
constexpr size_t WS_WGU2 = WS_WO + (size_t)D * D * 2;
constexpr size_t WS_WD2 = WS_WGU2 + (size_t)NGU * D * 2;
constexpr size_t WS_WSP = WS_WD2 + (size_t)D * FF * 2;
constexpr size_t WS_W_END = WS_WSP + (size_t)NG * CHUNK * CHUNK * 2;
static_assert(WS_W_END <= 50 * MiB, "weights");
constexpr size_t WS_XN = 50 * MiB;
constexpr size_t WS_MIX = 114 * MiB;
constexpr size_t WS_MERGED = 178 * MiB;
constexpr size_t WS_ACT = 242 * MiB;
constexpr size_t WS_P = 242 * MiB;
constexpr size_t WS_END = 482 * MiB;

__device__ __forceinline__ float fsigmoid(float v) { return __builtin_amdgcn_rcpf(1.0f + __builtin_amdgcn_exp2f(-LOG2E * v)); }
__device__ __forceinline__ float fgelu_tanh(float v) {
    const float u = 0.7978845608028654f * (v + 0.044715f * v * v * v);
    return v * fsigmoid(2.0f * u);
}

namespace pg8 {
constexpr int BM = 256, BK = 64, HALF = 128, HTB = HALF * BK * 2  , STAGE_BYTES = 8 * HTB, NXCD = 8, WGM = 8;

__host__ __device__ __forceinline__ int lds_byte(int r, int c) { const int st = (r >> 4) * 2 + (c >> 5), rr = r & 15, cc = c & 31, ob = rr * 64 + cc * 2; return st * 1024 + (ob ^ (((ob >> 9) & 1) << 5)); }
__host__ __device__ __forceinline__ void stage_rc(int b, int& R, int& C) { const int st = b / 1024, sb = b % 1024, swz = sb ^ (((sb >> 9) & 1) << 5); R = (st >> 1) * 16 + swz / 64; C = (st & 1) * 32 + (swz % 64) / 2; }
__host__ __device__ __forceinline__ int perm32(int rho) { const int n = rho >> 4, i = rho & 15; return 8 * (i >> 2) + 4 * n + (i & 3); }

struct Unit { int pm, pn, seg; };
struct Gemm { const bf16_t* A0; const bf16_t* A1; const bf16_t* B0; const bf16_t* B1; int lda, ldb, K; };

struct StaticOrder {
    int nM, nN, nwg, G, c, nseg;
    __host__ __device__ void init(int M_, int N_, int G_, int c_, int nseg_ = 1) { nM = M_ / BM; nN = N_ / BM; nwg = nM * nN; G = G_; c = c_; nseg = nseg_; }
    __host__ __device__ bool next(int i, Unit& u) const {
        const int ti = (nseg == 1) ? i : (i >> 1);
        const long L = (long)ti * G + c; if (L >= nwg) return false;
        int wgid = (int)L; { const int q = nwg / NXCD, r = nwg % NXCD, xcd = wgid % NXCD, off = wgid / NXCD; wgid = (xcd < r ? xcd * (q + 1) : r * (q + 1) + (xcd - r) * q) + off; }
        const int nig = WGM * nN, gid = wgid / nig, fm = gid * WGM, gsz = (nM - fm) < WGM ? (nM - fm) : WGM;
        u.pm = fm + ((wgid % nig) % gsz); u.pn = (wgid % nig) / gsz; u.seg = (nseg == 1) ? 0 : (i & 1); return true;
    }
};

template <class Epi, class Sched>
__device__ __forceinline__ void gemm_phase(LAS unsigned char* lds, const Gemm g, const Sched& S, const Epi& E) {
    const int tid = threadIdx.x, wid = __builtin_amdgcn_readfirstlane(tid >> 6), lane = tid & 63, wr = wid >> 2, wc = wid & 3, fr = lane & 15, fq = lane >> 4;
    const int nt = g.K / BK;
    unsigned voffA[2], voffB[2];
#pragma unroll
    for (int i = 0; i < 2; ++i) { int R, C; stage_rc(tid * 16 + i * 8192, R, C); const int Rb = (R & ~31) + perm32(R & 31);
        voffA[i] = (unsigned)(R * g.lda + C) * 2u; voffB[i] = (unsigned)(Rb * g.ldb + C) * 2u; }
    const size_t kstep = (size_t)(BK * 2);
    const size_t hstepA = (size_t)HALF * g.lda * 2, hstepB = (size_t)HALF * g.ldb * 2;
    const size_t tstepA = 2 * hstepA, tstepB = 2 * hstepB;
    const unsigned ldsw = (unsigned)wid * 1024u;
    const int aoff = lds_byte(wr * 64 + fr, fq * 8), boff = lds_byte(wc * 32 + fr, fq * 8);
#define PG8_SA(b, h) (((b) * 2 + (h)) * HTB)
#define PG8_SB(b, h) ((4 + (b) * 2 + (h)) * HTB)
#define PG8_STAGE(bufoff, gbase, voff) do { _Pragma("unroll") for (int _i = 0; _i < 2; ++_i) \
        __builtin_amdgcn_global_load_lds((const unsigned*)((const char*)(gbase) + (voff)[_i]), (LAS unsigned*)(lds + (bufoff) + ldsw + _i * 8192), 16, 0, 0); } while (0)
#define PG8_LDA(dst, b, h) do { _Pragma("unroll") for (int m = 0; m < 4; ++m) _Pragma("unroll") for (int k = 0; k < 2; ++k) dst[m][k] = *(const LAS bf16x8*)(lds + PG8_SA(b, h) + aoff + m * 2048 + k * 1024); } while (0)
#define PG8_LDB(dst, b, h) do { _Pragma("unroll") for (int n = 0; n < 2; ++n) _Pragma("unroll") for (int k = 0; k < 2; ++k) dst[n][k] = *(const LAS bf16x8*)(lds + PG8_SB(b, h) + boff + n * 2048 + k * 1024); } while (0)
#define PG8_MMA(ai, bj, At, Bt) do { __builtin_amdgcn_s_setprio(1); _Pragma("unroll") for (int m = 0; m < 4; ++m) _Pragma("unroll") for (int n = 0; n < 2; ++n) _Pragma("unroll") for (int k = 0; k < 2; ++k) \
        acc[ai][bj][m][n] = __builtin_amdgcn_mfma_f32_16x16x32_bf16(Bt[n][k], At[m][k], acc[ai][bj][m][n], 0, 0, 0); __builtin_amdgcn_s_setprio(0); } while (0)
#define PG8_WAIT_V(n) asm volatile("s_waitcnt vmcnt(" #n ")" ::: "memory")
#define PG8_WAIT_L(n) asm volatile("s_waitcnt lgkmcnt(" #n ")" ::: "memory")
#define PG8_BAR __builtin_amdgcn_s_barrier()
#define PG8_SCHED __builtin_amdgcn_sched_barrier(0)
    Unit cur, nxt; int ui = 0;
    if (!S.next(0, cur)) return;
    f32x4 acc[2][2][4][2];
#pragma unroll
    for (int a = 0; a < 2; ++a)
#pragma unroll
        for (int b = 0; b < 2; ++b)
#pragma unroll
            for (int m = 0; m < 4; ++m)
#pragma unroll
                for (int n = 0; n < 2; ++n) acc[a][b][m][n] = (f32x4){0.f, 0.f, 0.f, 0.f};
    bf16x8 At[4][2], B0[2][2], B1[2][2];
    const char* cA = (const char*)(cur.seg ? g.A1 : g.A0) + (size_t)cur.pm * tstepA; const char* cB = (const char*)(cur.seg ? g.B1 : g.B0) + (size_t)cur.pn * tstepB;
    PG8_STAGE(PG8_SB(0, 0), cB, voffB); PG8_STAGE(PG8_SB(0, 1), cB + hstepB, voffB); PG8_STAGE(PG8_SA(0, 0), cA, voffA); PG8_STAGE(PG8_SA(0, 1), cA + hstepA, voffA);
    if (wr == 1) PG8_BAR;
    PG8_WAIT_V(2); PG8_BAR;
    PG8_STAGE(PG8_SB(1, 0), cB + kstep, voffB); PG8_STAGE(PG8_SA(1, 0), cA + kstep, voffA); PG8_STAGE(PG8_SB(1, 1), cB + hstepB + kstep, voffB);
    PG8_WAIT_V(6); PG8_BAR;
    for (;;) {
        const bool has_next = S.next(ui + 1, nxt);
        const char* nA = has_next ? (const char*)(nxt.seg ? g.A1 : g.A0) + (size_t)nxt.pm * tstepA : cA; const char* nB = has_next ? (const char*)(nxt.seg ? g.B1 : g.B0) + (size_t)nxt.pn * tstepB : cB;
        for (int t = 0; t < nt; t += 2) {
            const bool last = (t == nt - 2);
            const char* a1 = cA + (size_t)(t + 1) * kstep;
            const char* a2 = last ? nA : cA + (size_t)(t + 2) * kstep; const char* b2 = last ? nB : cB + (size_t)(t + 2) * kstep;
            const char* a3 = a2 + kstep; const char* b3 = b2 + kstep;
            PG8_LDB(B0, 0, 0); PG8_LDB(B1, 0, 1); PG8_SCHED; PG8_LDA(At, 0, 0); PG8_STAGE(PG8_SA(1, 1), a1 + hstepA, voffA);
            PG8_WAIT_V(8); PG8_WAIT_L(0); PG8_BAR; PG8_MMA(0, 0, At, B0); PG8_MMA(0, 1, At, B1); PG8_BAR; PG8_SCHED;
            PG8_LDA(At, 0, 1); PG8_STAGE(PG8_SB(0, 0), b2, voffB); PG8_STAGE(PG8_SB(0, 1), b2 + hstepB, voffB); PG8_STAGE(PG8_SA(0, 0), a2, voffA);
            PG8_WAIT_V(8); PG8_WAIT_L(0); PG8_BAR; PG8_MMA(1, 0, At, B0); PG8_MMA(1, 1, At, B1); PG8_BAR; PG8_SCHED;
            PG8_LDB(B0, 1, 0); PG8_LDB(B1, 1, 1); PG8_SCHED; PG8_LDA(At, 1, 0); PG8_STAGE(PG8_SA(0, 1), a2 + hstepA, voffA);
            PG8_WAIT_V(8); PG8_WAIT_L(0); PG8_BAR; PG8_MMA(0, 0, At, B0); PG8_MMA(0, 1, At, B1); PG8_BAR; PG8_SCHED;
            PG8_LDA(At, 1, 1); PG8_STAGE(PG8_SB(1, 0), b3, voffB); PG8_STAGE(PG8_SB(1, 1), b3 + hstepB, voffB); PG8_STAGE(PG8_SA(1, 0), a3, voffA);
            PG8_WAIT_V(8); PG8_WAIT_L(0); PG8_BAR; PG8_MMA(1, 0, At, B0); PG8_MMA(1, 1, At, B1); PG8_BAR; PG8_SCHED;
        }
        if (wr == 0) PG8_BAR;
        const bool keep = E(acc, cur, wr, wc, fr, fq);
        if (!has_next) break;
        if (!keep) {
#pragma unroll
            for (int a = 0; a < 2; ++a)
#pragma unroll
                for (int b = 0; b < 2; ++b)
#pragma unroll
                    for (int m = 0; m < 4; ++m)
#pragma unroll
                        for (int n = 0; n < 2; ++n) acc[a][b][m][n] = (f32x4){0.f, 0.f, 0.f, 0.f};
        }
        cur = nxt; cA = nA; cB = nB; ++ui;
        if (wr == 1) PG8_BAR;
    }
    PG8_WAIT_V(0);
    PG8_BAR;
#undef PG8_SA
#undef PG8_SB
#undef PG8_STAGE
#undef PG8_LDA
#undef PG8_LDB
#undef PG8_MMA
#undef PG8_WAIT_V
#undef PG8_WAIT_L
#undef PG8_BAR
#undef PG8_SCHED
}
}

using pg8::Unit;
__device__ __forceinline__ float rstd_of(const float* ss, int m) { return __builtin_amdgcn_rsqf(ss[m] * (1.0f / D) + EPS); }

struct EpiGU {
    bf16_t* act; const float* ss; const float* cb;
    __device__ __forceinline__ bool operator()(f32x4 (&acc)[2][2][4][2], const Unit& u, int wr, int wc, int fr, int fq) const {
        const int b = u.pm >> 3;
        const float* cbp = cb + b * NGU + u.pn * 256 + wc * 32 + 8 * fq;
        f32x4 cg[2], cu[2];
#pragma unroll
        for (int n = 0; n < 2; ++n) { cg[n] = *(const f32x4*)(cbp + 4 * n); cu[n] = *(const f32x4*)(cbp + 128 + 4 * n); }
#pragma unroll
        for (int ai = 0; ai < 2; ++ai)
#pragma unroll
            for (int m = 0; m < 4; ++m) {
                const int row = u.pm * 256 + ai * 128 + wr * 64 + m * 16 + fr; const float rs = rstd_of(ss, row);
                unsigned w[4];
#pragma unroll
                for (int n = 0; n < 2; ++n) { const f32x4 gv = acc[ai][0][m][n] * rs + cg[n], uv = acc[ai][1][m][n] * rs + cu[n]; float o[4];
#pragma unroll
                    for (int i = 0; i < 4; ++i) o[i] = gv[i] * uv[i] * fsigmoid(gv[i]);
                    w[2 * n] = cvt_pk_bf16(o[0], o[1]); w[2 * n + 1] = cvt_pk_bf16(o[2], o[3]); }
                *(u32x4*)(act + (size_t)row * FF + u.pn * 128 + wc * 32 + 8 * fq) = (u32x4){w[0], w[1], w[2], w[3]};
            }
        return false;
    }
};
template <bool NORM> struct EpiRes {
    const float* resid; float* hout; const float* ga; const float* gn; const float* sc; bf16_t* xn; float* ssq; float gscale;
    __device__ __forceinline__ bool operator()(f32x4 (&acc)[2][2][4][2], const Unit& u, int wr, int wc, int fr, int fq) const {
        const int b = u.pm >> 3; constexpr bool donorm = NORM;
        f32x4 gav[2][2], gsv[2][2];
#pragma unroll
        for (int bj = 0; bj < 2; ++bj)
#pragma unroll
            for (int n = 0; n < 2; ++n) { const int c = u.pn * 256 + bj * 128 + wc * 32 + 8 * fq + 4 * n;
                gav[bj][n] = *(const f32x4*)(ga + b * NMOD + c) * gscale;
                if constexpr (NORM) gsv[bj][n] = *(const f32x4*)(gn + c) * (*(const f32x4*)(sc + b * NMOD + c) + 1.0f); }
#pragma unroll
        for (int ai = 0; ai < 2; ++ai)
#pragma unroll
            for (int m = 0; m < 4; ++m) {
                const int row = u.pm * 256 + ai * 128 + wr * 64 + m * 16 + fr; float s = 0.f;
#pragma unroll
                for (int bj = 0; bj < 2; ++bj) { const size_t off = (size_t)row * D + u.pn * 256 + bj * 128 + wc * 32 + 8 * fq;
                    const f32x4 r0 = *(const f32x4*)(resid + off), r1 = *(const f32x4*)(resid + off + 4);
                    const f32x4 v0 = r0 + gav[bj][0] * acc[ai][bj][m][0], v1 = r1 + gav[bj][1] * acc[ai][bj][m][1];
                    *(f32x4*)(hout + off) = v0; *(f32x4*)(hout + off + 4) = v1;
                    if constexpr (NORM) { const f32x4 a0 = v0 * gsv[bj][0], a1 = v1 * gsv[bj][1];
                        *(u32x4*)(xn + off) = (u32x4){cvt_pk_bf16(a0[0], a0[1]), cvt_pk_bf16(a0[2], a0[3]), cvt_pk_bf16(a1[0], a1[1]), cvt_pk_bf16(a1[2], a1[3])};
                        s += (v0[0] * v0[0] + v0[1] * v0[1]) + (v0[2] * v0[2] + v0[3] * v0[3]) + (v1[0] * v1[0] + v1[1] * v1[1]) + (v1[2] * v1[2] + v1[3] * v1[3]); } }
                if constexpr (NORM) { s += __shfl_xor(s, 16); s += __shfl_xor(s, 32); if (fq == 0) atomicAdd(ssq + row, s); }
                if (m & 1) asm volatile("" ::: "memory");
            }
        return false;
    }
};
struct EpiWin {
    bf16_t* P; const float* ss; const float* cb;
    __device__ __forceinline__ bool operator()(f32x4 (&acc)[2][2][4][2], const Unit& u, int wr, int wc, int fr, int fq) const {
        const int b = u.pm >> 3; const int kind = u.pn < 4 ? 0 : (u.pn < 7 ? 1 : 2);
        f32x4 cv[2][2];
#pragma unroll
        for (int bj = 0; bj < 2; ++bj)
#pragma unroll
            for (int n = 0; n < 2; ++n) cv[bj][n] = *(const f32x4*)(cb + b * NIN + u.pn * 256 + bj * 128 + wc * 32 + 8 * fq + 4 * n);
#pragma unroll
        for (int ai = 0; ai < 2; ++ai)
#pragma unroll
            for (int m = 0; m < 4; ++m) {
                const int row = u.pm * 256 + ai * 128 + wr * 64 + m * 16 + fr; const float rs = rstd_of(ss, row);
#pragma unroll
                for (int bj = 0; bj < 2; ++bj) { unsigned w[4];
#pragma unroll
                    for (int n = 0; n < 2; ++n) { f32x4 v = acc[ai][bj][m][n] * rs + cv[bj][n];
                        if (kind == 0) { v[0] = fgelu_tanh(v[0]); v[1] = fgelu_tanh(v[1]); v[2] = fgelu_tanh(v[2]); v[3] = fgelu_tanh(v[3]); }
                        else if (kind == 2) { v[0] = fsigmoid(v[0]); v[1] = fsigmoid(v[1]); v[2] = fsigmoid(v[2]); v[3] = fsigmoid(v[3]); }
                        w[2 * n] = cvt_pk_bf16(v[0], v[1]); w[2 * n + 1] = cvt_pk_bf16(v[2], v[3]); }
                    *(u32x4*)(P + (size_t)row * NIN + u.pn * 256 + bj * 128 + wc * 32 + 8 * fq) = (u32x4){w[0], w[1], w[2], w[3]}; }
            }
        return false;
    }
};
struct EpiBranch {
    const bf16_t* P; bf16_t* merged;
    __device__ __forceinline__ bool operator()(f32x4 (&acc)[2][2][4][2], const Unit& u, int wr, int wc, int fr, int fq) const {
#pragma unroll
        for (int ai = 0; ai < 2; ++ai)
#pragma unroll
            for (int m = 0; m < 4; ++m) {
                const int row = u.pm * 256 + ai * 128 + wr * 64 + m * 16 + fr;
#pragma unroll
                for (int bj = 0; bj < 2; ++bj) { const int c = u.pn * 256 + bj * 128 + wc * 32 + 8 * fq;
                    const u32x4 gb = *(const u32x4*)(P + (size_t)row * NIN + PC_GB + c);
                    float sb[8] = {bflo(gb[0]), bfhi(gb[0]), bflo(gb[1]), bfhi(gb[1]), bflo(gb[2]), bfhi(gb[2]), bflo(gb[3]), bfhi(gb[3])};
                    if (u.seg == 0) {
                        const u32x4 gaw = *(const u32x4*)(P + (size_t)row * NIN + PC_GA + c);
                        const float sa[8] = {bflo(gaw[0]), bfhi(gaw[0]), bflo(gaw[1]), bfhi(gaw[1]), bflo(gaw[2]), bfhi(gaw[2]), bflo(gaw[3]), bfhi(gaw[3])};
#pragma unroll
                        for (int i = 0; i < 4; ++i) { acc[ai][bj][m][0][i] *= sa[i] * __builtin_amdgcn_rcpf(fmaxf(sb[i], 1e-30f)); acc[ai][bj][m][1][i] *= sa[4 + i] * __builtin_amdgcn_rcpf(fmaxf(sb[4 + i], 1e-30f)); }
                    } else {
                        const f32x4 a0 = acc[ai][bj][m][0], a1 = acc[ai][bj][m][1];
                        *(u32x4*)(merged + (size_t)row * D + c) = (u32x4){cvt_pk_bf16(a0[0] * sb[0], a0[1] * sb[1]), cvt_pk_bf16(a0[2] * sb[2], a0[3] * sb[3]), cvt_pk_bf16(a1[0] * sb[4], a1[1] * sb[5]), cvt_pk_bf16(a1[2] * sb[6], a1[3] * sb[7])};
                    } }
                if (m & 1) asm volatile("" ::: "memory");
            }
        return u.seg == 0;
    }
};

#define XB_TMO      128
#define XB_XCNT(j)  (256  + 64 * (j))
#define XB_XSUB(j)  (1280 + 64 * (j))
#define XB_XGEN(j)  (2304 + 64 * (j))
#define XB_TOP      3328
#define XB_TOPGEN   3392
#define XCD_BAR_WORDS 3456
#define XB_SPIN_CAP (1u << 18)

__device__ __forceinline__ unsigned xb_ld(unsigned* p)              { return __hip_atomic_load(p, __ATOMIC_RELAXED, __HIP_MEMORY_SCOPE_AGENT); }
__device__ __forceinline__ unsigned xb_add(unsigned* p, unsigned v) { return __hip_atomic_fetch_add(p, v, __ATOMIC_RELAXED, __HIP_MEMORY_SCOPE_AGENT); }
__device__ __forceinline__ unsigned xb_xcc_id() { return (unsigned)__builtin_amdgcn_s_getreg((3 << 11) | 20) & 0xFu; }
#define XB_SPIN(cond, bar) do { unsigned _sp = 0; while (cond) { __builtin_amdgcn_s_sleep(1); \
    if ((++_sp & 255u) == 0u) { if (xb_ld(&(bar)[XB_TMO])) break; if (_sp > XB_SPIN_CAP) { atomicAdd(&(bar)[XB_TMO], 1u); break; } } } } while (0)

struct XcdBarrier {
    unsigned* bar; unsigned x;
    volatile LAS unsigned* st;
};

__device__ __forceinline__ XcdBarrier xcd_barrier_post(unsigned* bar, volatile LAS unsigned* st) {
    XcdBarrier b; b.bar = bar; b.x = xb_xcc_id(); b.st = st;
    if (threadIdx.x == 0) (void)xb_add(&bar[XB_XCNT(b.x)], 1u);
    return b;
}
__device__ __forceinline__ void xcd_barrier_complete(unsigned* bar, unsigned x, unsigned& nloc, unsigned& nx) {
    const unsigned G = gridDim.x * gridDim.y * gridDim.z;
    unsigned sum, cnt, mine, sp = 0u;
    for (;;) {
        sum = 0u; cnt = 0u; mine = 0u;
#pragma unroll
        for (unsigned j = 0; j < 16; ++j) { const unsigned c = xb_ld(&bar[XB_XCNT(j)]); sum += c; cnt += (c > 0u) ? 1u : 0u; mine = (j == x) ? c : mine; }
        if (sum == G) break;
        __builtin_amdgcn_s_sleep(1);
        if ((++sp & 255u) == 0u) { if (xb_ld(&bar[XB_TMO])) break; if (sp > XB_SPIN_CAP) { atomicAdd(&bar[XB_TMO], 1u); break; } }
    }
    nloc = mine > 0u ? mine : 1u; nx = cnt > 0u ? cnt : 1u;
}

__device__ __forceinline__ void xcd_barrier(const XcdBarrier& b) {
    asm volatile("s_waitcnt vmcnt(0)" ::: "memory");
    __syncthreads();
    if (threadIdx.x == 0) {
        unsigned* bar = b.bar;
        __builtin_amdgcn_s_waitcnt(0);
        unsigned nloc = b.st[0], nx = b.st[1];
        if (nloc == 0u) { xcd_barrier_complete(bar, b.x, nloc, nx); b.st[0] = nloc; b.st[1] = nx; }
        const unsigned old = xb_add(&bar[XB_XSUB(b.x)], 1u);
        const unsigned gen = old / nloc;
        if (old + 1u == (gen + 1u) * nloc) {
            __builtin_amdgcn_fence(__ATOMIC_RELEASE, "agent");
            asm volatile("s_waitcnt vmcnt(0)" ::: "memory");
            const unsigned og = xb_add(&bar[XB_TOP], 1u);
            const unsigned tg = og / nx;
            if (og + 1u == (tg + 1u) * nx) xb_add(&bar[XB_TOPGEN], 1u);
            else XB_SPIN(xb_ld(&bar[XB_TOPGEN]) == tg, bar);
            __builtin_amdgcn_fence(__ATOMIC_ACQUIRE, "agent");
            xb_add(&bar[XB_XGEN(b.x)], 1u);
            asm volatile("s_waitcnt vmcnt(0)" ::: "memory");
        } else {
            XB_SPIN(xb_ld(&bar[XB_XGEN(b.x)]) == gen, bar);
            __builtin_amdgcn_fence(__ATOMIC_ACQUIRE, "agent");
            asm volatile("s_waitcnt vmcnt(0)" ::: "memory");
        }
    }
    __syncthreads();
}

constexpr int NWAVES = 8;
constexpr int RING_OFF = 0, RING_BYTES = 131072;
constexpr int LDSCTL_OFF = RING_BYTES, MISC_OFF = LDSCTL_OFF + 320;
constexpr int LDS_BYTES = 147456;
static_assert(MISC_OFF + 128 <= LDS_BYTES, "LDS map");

struct Frame {
    LAS unsigned char* lds;
    volatile LAS unsigned* MISC;
    int tid, lane, wave;
    int vcu, G;
};
struct Args { const float* in[24]; float* out; unsigned char* ws; int ph_lo, ph_hi, li, pad; };

__device__ __forceinline__ float wave_sum(float v) {
#pragma unroll
    for (int o = 1; o < 64; o <<= 1) v += __shfl_xor(v, o);
    return v;
}
__device__ __forceinline__ void p0_mods_item(const Frame& F, const float* c, const float* w_ada, const float* b_ada, float* mods, int item, bool fill) {
    LAS float* sc = (LAS float*)(F.lds + RING_OFF);
    LAS float* red = (LAS float*)(F.lds + RING_OFF + 65536);
    if (fill) { for (int i = F.tid; i < BATCH * D; i += NWAVES * 64) { const float v = c[i]; sc[i] = v * fsigmoid(v); } __syncthreads(); }
    const int j = item * 64 + F.lane, k0 = F.wave * 128;
    float acc[BATCH];
#pragma unroll
    for (int b = 0; b < BATCH; ++b) acc[b] = 0.f;
#pragma unroll 4
    for (int k = k0; k < k0 + 128; ++k) { const float wv = w_ada[(size_t)k * NMOD + j];
#pragma unroll
        for (int b = 0; b < BATCH; ++b) acc[b] += sc[b * D + k] * wv; }
#pragma unroll
    for (int b = 0; b < BATCH; ++b) red[(F.wave * BATCH + b) * 64 + F.lane] = acc[b];
    __syncthreads();
    for (int i = F.tid; i < BATCH * 64; i += NWAVES * 64) { const int b = i >> 6, l = i & 63; float s = 0.f;
#pragma unroll
        for (int w = 0; w < NWAVES; ++w) s += red[(w * BATCH + b) * 64 + l];
        mods[b * NMOD + item * 64 + l] = s + b_ada[item * 64 + l]; }
    __syncthreads();
}
__device__ __forceinline__ void p0_transpose_item(const float* W, int K, int N, bf16_t* WT, int gu, LAS float* scr, int item, int lane) {
    const int nblk = N / 32, kb = item / nblk, nb = item % nblk, k0 = 64 * kb, n0 = 32 * nb;
#pragma unroll 8
    for (int i = 0; i < 32; ++i) { const int kk = 2 * i + (lane >> 5); scr[kk * 33 + (lane & 31)] = W[(size_t)(k0 + kk) * N + n0 + (lane & 31)]; }
    LDS_WAIT(); asm volatile("" ::: "memory");
    const int c = lane & 7;
    const int r0 = gu ? (256 * (n0 >> 7) + (n0 & 127) + 128 * (gu - 1)) : n0;
#pragma unroll
    for (int j = 0; j < 4; ++j) { const int n = (lane >> 3) + 8 * j; const LAS float* s = scr + (8 * c) * 33 + n;
        u32x4 o; o.x = pk2(s[0 * 33], s[1 * 33]); o.y = pk2(s[2 * 33], s[3 * 33]); o.z = pk2(s[4 * 33], s[5 * 33]); o.w = pk2(s[6 * 33], s[7 * 33]);
        *(GAS u32x4*)(WT + (size_t)(r0 + n) * K + k0 + 8 * c) = o; }
    LDS_WAIT(); asm volatile("" ::: "memory");
}
struct WsPtrs {
    float *mods, *cb1, *cb2, *cb3, *ss1, *ss2, *ss3;
    bf16_t *WGU1, *WD1, *WIN, *WA, *WB, *WO, *WGU2, *WD2, *WSP, *XN, *MIX, *MERGED, *ACT, *P;
};
__device__ __forceinline__ void p0_prologue(const Frame& F, const Args& a, const WsPtrs& w) {
    if (F.vcu < NMOD / 64) p0_mods_item(F, a.in[1], a.in[2], a.in[3], w.mods, F.vcu, true);
    LAS float* scr = (LAS float*)(F.lds + RING_OFF + F.wave * 16384);
    const int gw = F.vcu * NWAVES + F.wave, NGW = F.G * NWAVES;
    constexpr int I_G = (D / 64) * (FF / 32), I_D = (FF / 64) * (D / 32), I_IN = (D / 64) * (NIN / 32), I_AB = (DA / 64) * (D / 32), I_O = (D / 64) * (D / 32);
    constexpr int NITEMS = 4 * I_G + 2 * I_D + I_IN + 2 * I_AB + I_O;
    for (int it = gw; it < NITEMS; it += NGW) {
        int r = it;
        if (r < I_G) { p0_transpose_item(a.in[5], D, FF, w.WGU1, 1, scr, r, F.lane); continue; } r -= I_G;
        if (r < I_G) { p0_transpose_item(a.in[6], D, FF, w.WGU1, 2, scr, r, F.lane); continue; } r -= I_G;
        if (r < I_D) { p0_transpose_item(a.in[7], FF, D, w.WD1, 0, scr, r, F.lane); continue; } r -= I_D;
        if (r < I_IN) { p0_transpose_item(a.in[9], D, NIN, w.WIN, 0, scr, r, F.lane); continue; } r -= I_IN;
        if (r < I_AB) { p0_transpose_item(a.in[17], DA, D, w.WA, 0, scr, r, F.lane); continue; } r -= I_AB;
        if (r < I_AB) { p0_transpose_item(a.in[18], DB, D, w.WB, 0, scr, r, F.lane); continue; } r -= I_AB;
        if (r < I_O) { p0_transpose_item(a.in[19], D, D, w.WO, 0, scr, r, F.lane); continue; } r -= I_O;
        if (r < I_G) { p0_transpose_item(a.in[21], D, FF, w.WGU2, 1, scr, r, F.lane); continue; } r -= I_G;
        if (r < I_G) { p0_transpose_item(a.in[22], D, FF, w.WGU2, 2, scr, r, F.lane); continue; } r -= I_G;
        p0_transpose_item(a.in[23], FF, D, w.WD2, 0, scr, r, F.lane);
    }
    for (int i = (F.vcu * NWAVES * 64 + F.tid); i < NG * CHUNK * CHUNK; i += F.G * NWAVES * 64) { const int s = i & 127, t = (i >> 7) & 127; w.WSP[i] = (bf16_t)f2bf(s <= t ? a.in[12][i] : 0.f); }
}
__device__ __forceinline__ void p1_cb_rows(const Frame& F, const float* mods, int which, const bf16_t* Wt, int N, float* cb, int gw, int NGW) {
    for (int r = gw; r < N; r += NGW) {
        const u32x4 w0 = *(const u32x4*)(Wt + (size_t)r * D + F.lane * 16), w1 = *(const u32x4*)(Wt + (size_t)r * D + F.lane * 16 + 8);
        const float wv[16] = {bflo(w0[0]), bfhi(w0[0]), bflo(w0[1]), bfhi(w0[1]), bflo(w0[2]), bfhi(w0[2]), bflo(w0[3]), bfhi(w0[3]),
                              bflo(w1[0]), bfhi(w1[0]), bflo(w1[1]), bfhi(w1[1]), bflo(w1[2]), bfhi(w1[2]), bflo(w1[3]), bfhi(w1[3])};
        float res = 0.f;
#pragma unroll 4
        for (int b = 0; b < BATCH; ++b) { const float* sh = mods + b * NMOD + 3 * which * D + F.lane * 16; float s = 0.f;
#pragma unroll
            for (int q = 0; q < 4; ++q) { const f32x4 v = *(const f32x4*)(sh + 4 * q); s += v[0] * wv[4 * q] + v[1] * wv[4 * q + 1] + v[2] * wv[4 * q + 2] + v[3] * wv[4 * q + 3]; }
            s = wave_sum(s); if (F.lane == b) res = s; }
        if (F.lane < BATCH) cb[F.lane * N + r] = res;
    }
}
__device__ __forceinline__ void p1_phase(const Frame& F, const Args& a, const WsPtrs& w) {
    const int gw = F.vcu * NWAVES + F.wave, NGW = F.G * NWAVES;
    for (int blk = gw; blk < M / 16; blk += NGW) {
        const int m0 = blk * 16, b = m0 >> 11;
        f32x4 gsv[2][2];
#pragma unroll
        for (int j = 0; j < 2; ++j)
#pragma unroll
            for (int h = 0; h < 2; ++h) { const int k = j * 512 + F.lane * 8 + h * 4; gsv[j][h] = *(const f32x4*)(a.in[4] + k) * (*(const f32x4*)(w.mods + b * NMOD + 1 * D + k) + 1.0f); }
        for (int r = 0; r < 16; ++r) { const float* xr = a.in[0] + (size_t)(m0 + r) * D; float s = 0.f;
#pragma unroll
            for (int j = 0; j < 2; ++j) { const int k = j * 512 + F.lane * 8;
                const f32x4 v0 = *(const f32x4*)(xr + k), v1 = *(const f32x4*)(xr + k + 4);
                s += (v0[0] * v0[0] + v0[1] * v0[1]) + (v0[2] * v0[2] + v0[3] * v0[3]) + (v1[0] * v1[0] + v1[1] * v1[1]) + (v1[2] * v1[2] + v1[3] * v1[3]);
                const f32x4 a0 = v0 * gsv[j][0], a1 = v1 * gsv[j][1];
                *(u32x4*)(w.XN + (size_t)(m0 + r) * D + k) = (u32x4){cvt_pk_bf16(a0[0], a0[1]), cvt_pk_bf16(a0[2], a0[3]), cvt_pk_bf16(a1[0], a1[1]), cvt_pk_bf16(a1[2], a1[3])}; }
            s = wave_sum(s); if (F.lane == 0) w.ss1[m0 + r] = s; }
    }
    p1_cb_rows(F, w.mods, 0, w.WGU1, NGU, w.cb1, gw, NGW);
    p1_cb_rows(F, w.mods, 1, w.WIN, NIN, w.cb2, gw, NGW);
    p1_cb_rows(F, w.mods, 2, w.WGU2, NGU, w.cb3, gw, NGW);
}

__global__ void k_vln(const bf16_t* P, const float* g, const float* bta, bf16_t* vn) {
    const int m = (blockIdx.x * blockDim.x + threadIdx.x) >> 6, lane = threadIdx.x & 63;
    if (m >= M) return;
    float v[8], s = 0.f;
    for (int i = 0; i < 8; ++i) { v[i] = bf2f(P[(size_t)m * NIN + PC_V + i * 64 + lane]); s += v[i]; }
    for (int o = 1; o < 64; o <<= 1) s += __shfl_xor(s, o);
    const float mu = s * (1.0f / DA); float q = 0.f;
    for (int i = 0; i < 8; ++i) { v[i] -= mu; q += v[i] * v[i]; }
    for (int o = 1; o < 64; o <<= 1) q += __shfl_xor(q, o);
    const float rs = rsqrtf(q * (1.0f / DA) + EPS);
    for (int i = 0; i < 8; ++i) { const int c = i * 64 + lane; vn[(size_t)m * DA + c] = f2bf(v[i] * rs * g[c] + bta[c]); }
}
__global__ void k_sgu(const bf16_t* P, const bf16_t* vn, const bf16_t* wsp, const float* bsp, bf16_t* mix) {
    const int ch = threadIdx.x + (blockIdx.x & 1) * 256, m = blockIdx.x >> 1;
    const int t = m & 127, g = ch >> 7, m0 = m - t;
    float z = 0.f;
    for (int s = 0; s <= t; ++s) z += bf2f(wsp[(g * 128 + t) * 128 + s]) * bf2f(vn[(size_t)(m0 + s) * DA + ch]);
    z += bsp[g * 128 + t];
    mix[(size_t)m * D + ch] = f2bf(bf2f(P[(size_t)m * NIN + PC_U + ch]) * z);
}
__global__ __launch_bounds__(128) void k_attn(const bf16_t* P, const float* gq, const float* gk, const float* sinks, bf16_t* mix) {
    const int i = threadIdx.x, hq = blockIdx.x & 7, n = (blockIdx.x >> 3) & 15, b = blockIdx.x >> 7, h = hq >> 2;
    const int m = b * SEQ + n * 128 + i;
    float q[64], o[64]; float s2 = 0.f;
    for (int d = 0; d < 64; ++d) { q[d] = bf2f(P[(size_t)m * NIN + PC_Q + hq * 64 + d]); s2 += q[d] * q[d]; o[d] = 0.f; }
    const float qs = rsqrtf(s2 * (1.0f / 64) + EPS) * 0.125f;
    for (int d = 0; d < 64; ++d) q[d] *= qs * gq[d];
    const float sink = sinks[hq];
    float mx = sink, l = 1.0f;
    for (int dj = 127; dj >= 0; --dj) {
        const int kp = n * 128 + i - dj; if (kp < 0) continue;
        const bf16_t* kr = P + (size_t)(b * SEQ + kp) * NIN + PC_K + h * 64;
        float kk[64], k2 = 0.f;
        for (int d = 0; d < 64; ++d) { kk[d] = bf2f(kr[d]); k2 += kk[d] * kk[d]; }
        const float ks = rsqrtf(k2 * (1.0f / 64) + EPS); float sc = 0.f;
        for (int d = 0; d < 64; ++d) sc += q[d] * kk[d] * gk[d];
        sc *= ks;
        const float nm = fmaxf(mx, sc), f = __expf(mx - nm), p = __expf(sc - nm);
        const bf16_t* vr = P + (size_t)(b * SEQ + kp) * NIN + PC_VV + h * 64;
        for (int d = 0; d < 64; ++d) o[d] = o[d] * f + p * bf2f(vr[d]);
        l = l * f + p; mx = nm;
    }
    const float il = 1.0f / l;
    for (int d = 0; d < 64; ++d) mix[(size_t)m * D + 512 + hq * 64 + d] = f2bf(o[d] * il);
}


__device__ __forceinline__ void mixer_phase(const Frame& F, const Args& a, const WsPtrs& w) {}

__global__ void __launch_bounds__(NWAVES * 64, 2) mega_fwd(Args args) {
    extern __shared__ __attribute__((aligned(16))) unsigned char lds[];
    Frame F;
    F.lds = (LAS unsigned char*)lds;
    F.MISC = (volatile LAS unsigned*)(F.lds + MISC_OFF);
    F.tid = threadIdx.x; F.lane = F.tid & 63; F.wave = __builtin_amdgcn_readfirstlane(F.tid >> 6);
    F.G = gridDim.x; { const int bx = blockIdx.x; F.vcu = (F.G % 8 == 0) ? (bx % 8) * (F.G / 8) + bx / 8 : bx; }
    unsigned char* ws = args.ws;
    WsPtrs w;
    w.mods = (float*)(ws + WS_MODS); w.cb1 = (float*)(ws + WS_CB1); w.cb2 = (float*)(ws + WS_CB2); w.cb3 = (float*)(ws + WS_CB3);
    w.ss1 = (float*)(ws + WS_SS1); w.ss2 = (float*)(ws + WS_CTL + CTL_SS2); w.ss3 = (float*)(ws + WS_CTL + CTL_SS3);
    w.WGU1 = (bf16_t*)(ws + WS_WGU1); w.WD1 = (bf16_t*)(ws + WS_WD1); w.WIN = (bf16_t*)(ws + WS_WIN); w.WA = (bf16_t*)(ws + WS_WA); w.WB = (bf16_t*)(ws + WS_WB);
    w.WO = (bf16_t*)(ws + WS_WO); w.WGU2 = (bf16_t*)(ws + WS_WGU2); w.WD2 = (bf16_t*)(ws + WS_WD2); w.WSP = (bf16_t*)(ws + WS_WSP);
    w.XN = (bf16_t*)(ws + WS_XN); w.MIX = (bf16_t*)(ws + WS_MIX); w.MERGED = (bf16_t*)(ws + WS_MERGED); w.ACT = (bf16_t*)(ws + WS_ACT); w.P = (bf16_t*)(ws + WS_P);
    for (int u = F.tid; u < (LDS_BYTES - LDSCTL_OFF) / 4; u += NWAVES * 64) ((LAS unsigned*)(F.lds + LDSCTL_OFF))[u] = 0u;
    __syncthreads();
    XcdBarrier bar = xcd_barrier_post((unsigned*)(ws + WS_CTL) + CW_BAR + args.li * XCD_BAR_WORDS, F.MISC + 8);
    const int lo = args.ph_lo, hi = args.ph_hi;
#define IN(k) (lo <= (k) && (k) < hi)
#define SEAM(k) do { if (IN(k) && IN((k) + 1)) xcd_barrier(bar); } while (0)
    const int cid = (int)blockIdx.x;
    float* out = args.out;

    if (IN(0)) { p0_prologue(F, args, w); SEAM(0); }
    if (IN(1)) { p1_phase(F, args, w); SEAM(1); }
    if (IN(2)) {
        pg8::Gemm g{w.XN, w.XN, w.WGU1, w.WGU1, D, D, D}; pg8::StaticOrder S; S.init(M, NGU, F.G, cid);
        EpiGU E{w.ACT, w.ss1, w.cb1};
        pg8::gemm_phase(F.lds + RING_OFF, g, S, E); SEAM(2);
    }
    if (IN(3)) {
        pg8::Gemm g{w.ACT, w.ACT, w.WD1, w.WD1, FF, FF, FF}; pg8::StaticOrder S; S.init(M, D, F.G, cid);
        EpiRes<true> E{args.in[0], out, w.mods + 2 * D, args.in[8], w.mods + 4 * D, w.XN, w.ss2, 0.5f};
        pg8::gemm_phase(F.lds + RING_OFF, g, S, E); SEAM(3);
    }
    if (IN(4)) {
        pg8::Gemm g{w.XN, w.XN, w.WIN, w.WIN, D, D, D}; pg8::StaticOrder S; S.init(M, NIN, F.G, cid);
        EpiWin E{w.P, w.ss2, w.cb2};
        pg8::gemm_phase(F.lds + RING_OFF, g, S, E); SEAM(4);
    }
    if (IN(5)) {
        mixer_phase(F, args, w); SEAM(5);
    }
    if (IN(6)) {
        pg8::Gemm g{w.MIX, w.MIX + 512, w.WA, w.WB, D, DA, DA}; pg8::StaticOrder S; S.init(M, D, F.G, cid, 2);
        EpiBranch E{w.P, w.MERGED};
        pg8::gemm_phase(F.lds + RING_OFF, g, S, E); SEAM(6);
    }
    if (IN(7)) {
        pg8::Gemm g{w.MERGED, w.MERGED, w.WO, w.WO, D, D, D}; pg8::StaticOrder S; S.init(M, D, F.G, cid);
        EpiRes<true> E{out, out, w.mods + 5 * D, args.in[20], w.mods + 7 * D, w.XN, w.ss3, 1.0f};
        pg8::gemm_phase(F.lds + RING_OFF, g, S, E); SEAM(7);
    }
    if (IN(8)) {
        pg8::Gemm g{w.XN, w.XN, w.WGU2, w.WGU2, D, D, D}; pg8::StaticOrder S; S.init(M, NGU, F.G, cid);
        EpiGU E{w.ACT, w.ss3, w.cb3};
        pg8::gemm_phase(F.lds + RING_OFF, g, S, E); SEAM(8);
    }
    if (IN(9)) {
        pg8::Gemm g{w.ACT, w.ACT, w.WD2, w.WD2, FF, FF, FF}; pg8::StaticOrder S; S.init(M, D, F.G, cid);
        EpiRes<false> E{out, out, w.mods + 8 * D, nullptr, nullptr, nullptr, nullptr, 0.5f};
        pg8::gemm_phase(F.lds + RING_OFF, g, S, E);
    }
#undef IN
#undef SEAM
}

extern "C" void kernel_launch(void* const* d_in, const int* in_sizes, int n_in, void* d_out, int out_size, void* d_ws, size_t ws_size, hipStream_t stream) {
    static int grid = 0;
    if (grid == 0) {
        if (n_in != 24 || in_sizes[0] != M * D || out_size != M * D || ws_size < WS_END) {
            fprintf(stderr, "kernel_launch: unexpected shapes (n_in %d, in0 %d, out %d, ws %zu < %zu); nothing launched\n", n_in, n_in > 0 ? in_sizes[0] : -1, out_size, ws_size, (size_t)WS_END); grid = -1; return; }
        int dev = 0, cus = 0, per_cu = 0;
        if (hipGetDevice(&dev) != hipSuccess || hipDeviceGetAttribute(&cus, hipDeviceAttributeMultiprocessorCount, dev) != hipSuccess) { fprintf(stderr, "kernel_launch: device query failed\n"); grid = -1; return; }
        if (hipFuncSetAttribute((const void*)mega_fwd, hipFuncAttributeMaxDynamicSharedMemorySize, LDS_BYTES) != hipSuccess) { fprintf(stderr, "kernel_launch: hipFuncSetAttribute failed\n"); grid = -1; return; }
        if (hipOccupancyMaxActiveBlocksPerMultiprocessor(&per_cu, (const void*)mega_fwd, NWAVES * 64, LDS_BYTES) != hipSuccess || per_cu < 1) {
            fprintf(stderr, "kernel_launch: occupancy query reports %d workgroups per CU; nothing launched\n", per_cu); (void)hipGetLastError(); grid = -1; return; }
        grid = cus;
        fprintf(stderr, "kernel_launch: grid %d (occupancy query: %d per CU)\n", grid, per_cu);
    }
    if (grid < 0) return;
    (void)hipMemsetAsync((char*)d_ws + WS_CTL, 0, CTL_BYTES, stream);
    Args a; memset(&a, 0, sizeof a);
    for (int i = 0; i < 24; ++i) a.in[i] = (const float*)d_in[i];
    a.out = (float*)d_out; a.ws = (unsigned char*)d_ws;
#if N_LAUNCHES == 1
    a.ph_lo = 0; a.ph_hi = 10; a.li = 0;
    hipLaunchKernelGGL(mega_fwd, dim3(grid), dim3(NWAVES * 64), LDS_BYTES, stream, a);
#else
    a.ph_lo = 0; a.ph_hi = 5; a.li = 0;
    hipLaunchKernelGGL(mega_fwd, dim3(grid), dim3(NWAVES * 64), LDS_BYTES, stream, a);
    {
        unsigned char* ws = (unsigned char*)d_ws; const float* const* in = (const float* const*)d_in;
        bf16_t* P = (bf16_t*)(ws + WS_P); bf16_t* MIX = (bf16_t*)(ws + WS_MIX); bf16_t* VN = (bf16_t*)(ws + WS_MERGED); bf16_t* WSP = (bf16_t*)(ws + WS_WSP);
        k_vln<<<M / 4, 256, 0, stream>>>(P, in[10], in[11], VN);
        k_sgu<<<M * 2, 256, 0, stream>>>(P, VN, WSP, in[13], MIX);
        k_attn<<<BATCH * NCH * NQH, 128, 0, stream>>>(P, in[14], in[15], in[16], MIX);
    }
    a.ph_lo = 6; a.ph_hi = 10; a.li = 1;
    hipLaunchKernelGGL(mega_fwd, dim3(grid), dim3(NWAVES * 64), LDS_BYTES, stream, a);
#endif
}
```

```cpp
#include <hip/hip_runtime.h>
#include <cstdio>
#include <cstdint>
#include <cstring>
#ifndef N_LAUNCHES
#define N_LAUNCHES 1
#endif

typedef unsigned short bf16_t;
typedef short bf16x8 __attribute__((ext_vector_type(8)));
typedef float f32x4 __attribute__((ext_vector_type(4)));
typedef float f32x2 __attribute__((ext_vector_type(2)));
typedef unsigned u32x4 __attribute__((ext_vector_type(4)));
typedef unsigned u32x2 __attribute__((ext_vector_type(2)));
#define GAS __attribute__((address_space(1)))
#define LAS __attribute__((address_space(3)))
#define RLX_AGENT __ATOMIC_RELAXED, __HIP_MEMORY_SCOPE_AGENT
#define LDS_WAIT() asm volatile("s_waitcnt lgkmcnt(0)" ::: "memory")
#define VM_WAIT() asm volatile("s_waitcnt vmcnt(0)" ::: "memory")

__device__ __forceinline__ float bf2f(bf16_t h) { return __uint_as_float(((unsigned)h) << 16); }
__device__ __forceinline__ unsigned f2bf(float f) { unsigned u = __float_as_uint(f); return (u + 0x7fffu + ((u >> 16) & 1u)) >> 16; }
__device__ __forceinline__ unsigned pk2(float lo, float hi) { return f2bf(lo) | (f2bf(hi) << 16); }
__device__ __forceinline__ unsigned cvt_pk_bf16(float lo, float hi) { unsigned r; asm volatile("v_cvt_pk_bf16_f32 %0, %1, %2" : "=v"(r) : "v"(lo), "v"(hi)); return r; }
__device__ __forceinline__ float bflo(unsigned w) { return __uint_as_float(w << 16); }
__device__ __forceinline__ float bfhi(unsigned w) { return __uint_as_float(w & 0xffff0000u); }

constexpr int BATCH = 16, SEQ = 2048, D = 1024, M = BATCH * SEQ;
constexpr int FF = 2816, NGU = 2 * FF;
constexpr int DA = 512, DB = 512, NIN = 3840, NMOD = 9 * D;
constexpr int CHUNK = 128, NCH = SEQ / CHUNK, NG = 4, GD = 128;
constexpr int HD = 64, NQH = 8, NKVH = 2;
constexpr int PC_U = 0, PC_V = 512, PC_Q = 1024, PC_K = 1536, PC_VV = 1664, PC_GA = 1792, PC_GB = 2816;
constexpr float EPS = 1e-6f;
constexpr float LOG2E = 1.4426950408889634f;

constexpr size_t MiB = 1u << 20;
constexpr size_t WS_CTL = 0, CTL_BYTES = 1 * MiB;
constexpr int CW_BAR = 4096;
constexpr size_t CTL_SS2 = 256 * 1024, CTL_SS3 = 384 * 1024;
constexpr size_t WS_MODS = 1 * MiB;
constexpr size_t WS_CB1 = WS_MODS + 640 * 1024;
constexpr size_t WS_CB2 = WS_CB1 + 352 * 1024;
constexpr size_t WS_CB3 = WS_CB2 + 240 * 1024;
constexpr size_t WS_SS1 = WS_CB3 + 352 * 1024;
constexpr size_t WS_SMALL_END = WS_SS1 + 128 * 1024;
static_assert(WS_SMALL_END <= 4 * MiB, "small tables");
constexpr size_t WS_WGU1 = 4 * MiB;
constexpr size_t WS_WD1 = WS_WGU1 + (size_t)NGU * D * 2;
constexpr size_t WS_WIN = WS_WD1 + (size_t)D * FF * 2;
constexpr size_t WS_WA = WS_WIN + (size_t)NIN * D * 2;
constexpr size_t WS_WB = WS_WA + (size_t)D * DA * 2;
constexpr size_t WS_WO = WS_WB + (size_t)D * DB * 2;
constexpr size_t WS_WGU2 = WS_WO + (size_t)D * D * 2;
constexpr size_t WS_WD2 = WS_WGU2 + (size_t)NGU * D * 2;
constexpr size_t WS_WSP = WS_WD2 + (size_t)D * FF * 2;
constexpr size_t WS_W_END = WS_WSP + (size_t)NG * CHUNK * CHUNK * 2;
static_assert(WS_W_END <= 50 * MiB, "weights");
constexpr size_t WS_XN = 50 * MiB;
constexpr size_t WS_MIX = 114 * MiB;
constexpr size_t WS_MERGED = 178 * MiB;
constexpr size_t WS_ACT = 242 * MiB;
constexpr size_t WS_P = 242 * MiB;
constexpr size_t WS_END = 482 * MiB;

__device__ __forceinline__ float fsigmoid(float v) { return __builtin_amdgcn_rcpf(1.0f + __builtin_amdgcn_exp2f(-LOG2E * v)); }
__device__ __forceinline__ float fgelu_tanh(float v) {
    const float u = 0.7978845608028654f * (v + 0.044715f * v * v * v);
    return v * fsigmoid(2.0f * u);
}

namespace pg8 {
constexpr int BM = 256, BK = 64, HALF = 128, HTB = HALF * BK * 2  , STAGE_BYTES = 8 * HTB, NXCD = 8, WGM = 8;

__host__ __device__ __forceinline__ int lds_byte(int r, int c) { const int st = (r >> 4) * 2 + (c >> 5), rr = r & 15, cc = c & 31, ob = rr * 64 + cc * 2; return st * 1024 + (ob ^ (((ob >> 9) & 1) << 5)); }
__host__ __device__ __forceinline__ void stage_rc(int b, int& R, int& C) { const int st = b / 1024, sb = b % 1024, swz = sb ^ (((sb >> 9) & 1) << 5); R = (st >> 1) * 16 + swz / 64; C = (st & 1) * 32 + (swz % 64) / 2; }
__host__ __device__ __forceinline__ int perm32(int rho) { const int n = rho >> 4, i = rho & 15; return 8 * (i >> 2) + 4 * n + (i & 3); }

struct Unit { int pm, pn, seg; };
struct Gemm { const bf16_t* A0; const bf16_t* A1; const bf16_t* B0; const bf16_t* B1; int lda, ldb, K; };

struct StaticOrder {
    int nM, nN, nwg, G, c, nseg;
    __host__ __device__ void init(int M_, int N_, int G_, int c_, int nseg_ = 1) { nM = M_ / BM; nN = N_ / BM; nwg = nM * nN; G = G_; c = c_; nseg = nseg_; }
    __host__ __device__ bool next(int i, Unit& u) const {
        const int ti = (nseg == 1) ? i : (i >> 1);
        const long L = (long)ti * G + c; if (L >= nwg) return false;
        int wgid = (int)L; { const int q = nwg / NXCD, r = nwg % NXCD, xcd = wgid % NXCD, off = wgid / NXCD; wgid = (xcd < r ? xcd * (q + 1) : r * (q + 1) + (xcd - r) * q) + off; }
        const int nig = WGM * nN, gid = wgid / nig, fm = gid * WGM, gsz = (nM - fm) < WGM ? (nM - fm) : WGM;
        u.pm = fm + ((wgid % nig) % gsz); u.pn = (wgid % nig) / gsz; u.seg = (nseg == 1) ? 0 : (i & 1); return true;
    }
};

template <class Epi, class Sched>
__device__ __forceinline__ void gemm_phase(LAS unsigned char* lds, const Gemm g, const Sched& S, const Epi& E) {
    const int tid = threadIdx.x, wid = __builtin_amdgcn_readfirstlane(tid >> 6), lane = tid & 63, wr = wid >> 2, wc = wid & 3, fr = lane & 15, fq = lane >> 4;
    const int nt = g.K / BK;
    unsigned voffA[2], voffB[2];
#pragma unroll
    for (int i = 0; i < 2; ++i) { int R, C; stage_rc(tid * 16 + i * 8192, R, C); const int Rb = (R & ~31) + perm32(R & 31);
        voffA[i] = (unsigned)(R * g.lda + C) * 2u; voffB[i] = (unsigned)(Rb * g.ldb + C) * 2u; }
    const size_t kstep = (size_t)(BK * 2);
    const size_t hstepA = (size_t)HALF * g.lda * 2, hstepB = (size_t)HALF * g.ldb * 2;
    const size_t tstepA = 2 * hstepA, tstepB = 2 * hstepB;
    const unsigned ldsw = (unsigned)wid * 1024u;
    const int aoff = lds_byte(wr * 64 + fr, fq * 8), boff = lds_byte(wc * 32 + fr, fq * 8);
#define PG8_SA(b, h) (((b) * 2 + (h)) * HTB)
#define PG8_SB(b, h) ((4 + (b) * 2 + (h)) * HTB)
#define PG8_STAGE(bufoff, gbase, voff) do { _Pragma("unroll") for (int _i = 0; _i < 2; ++_i) \
        __builtin_amdgcn_global_load_lds((const unsigned*)((const char*)(gbase) + (voff)[_i]), (LAS unsigned*)(lds + (bufoff) + ldsw + _i * 8192), 16, 0, 0); } while (0)
#define PG8_LDA(dst, b, h) do { _Pragma("unroll") for (int m = 0; m < 4; ++m) _Pragma("unroll") for (int k = 0; k < 2; ++k) dst[m][k] = *(const LAS bf16x8*)(lds + PG8_SA(b, h) + aoff + m * 2048 + k * 1024); } while (0)
#define PG8_LDB(dst, b, h) do { _Pragma("unroll") for (int n = 0; n < 2; ++n) _Pragma("unroll") for (int k = 0; k < 2; ++k) dst[n][k] = *(const LAS bf16x8*)(lds + PG8_SB(b, h) + boff + n * 2048 + k * 1024); } while (0)
#define PG8_MMA(ai, bj, At, Bt) do { __builtin_amdgcn_s_setprio(1); _Pragma("unroll") for (int m = 0; m < 4; ++m) _Pragma("unroll") for (int n = 0; n < 2; ++n) _Pragma("unroll") for (int k = 0; k < 2; ++k) \
        acc[ai][bj][m][n] = __builtin_amdgcn_mfma_f32_16x16x32_bf16(Bt[n][k], At[m][k], acc[ai][bj][m][n], 0, 0, 0); __builtin_amdgcn_s_setprio(0); } while (0)
#define PG8_WAIT_V(n) asm volatile("s_waitcnt vmcnt(" #n ")" ::: "memory")
#define PG8_WAIT_L(n) asm volatile("s_waitcnt lgkmcnt(" #n ")" ::: "memory")
#define PG8_BAR __builtin_amdgcn_s_barrier()
#define PG8_SCHED __builtin_amdgcn_sched_barrier(0)
    Unit cur, nxt; int ui = 0;
    if (!S.next(0, cur)) return;
    f32x4 acc[2][2][4][2];
#pragma unroll
    for (int a = 0; a < 2; ++a)
#pragma unroll
        for (int b = 0; b < 2; ++b)
#pragma unroll
            for (int m = 0; m < 4; ++m)
#pragma unroll
                for (int n = 0; n < 2; ++n) acc[a][b][m][n] = (f32x4){0.f, 0.f, 0.f, 0.f};
    bf16x8 At[4][2], B0[2][2], B1[2][2];
    const char* cA = (const char*)(cur.seg ? g.A1 : g.A0) + (size_t)cur.pm * tstepA; const char* cB = (const char*)(cur.seg ? g.B1 : g.B0) + (size_t)cur.pn * tstepB;
    PG8_STAGE(PG8_SB(0, 0), cB, voffB); PG8_STAGE(PG8_SB(0, 1), cB + hstepB, voffB); PG8_STAGE(PG8_SA(0, 0), cA, voffA); PG8_STAGE(PG8_SA(0, 1), cA + hstepA, voffA);
    if (wr == 1) PG8_BAR;
    PG8_WAIT_V(2); PG8_BAR;
    PG8_STAGE(PG8_SB(1, 0), cB + kstep, voffB); PG8_STAGE(PG8_SA(1, 0), cA + kstep, voffA); PG8_STAGE(PG8_SB(1, 1), cB + hstepB + kstep, voffB);
    PG8_WAIT_V(6); PG8_BAR;
    for (;;) {
        const bool has_next = S.next(ui + 1, nxt);
        const char* nA = has_next ? (const char*)(nxt.seg ? g.A1 : g.A0) + (size_t)nxt.pm * tstepA : cA; const char* nB = has_next ? (const char*)(nxt.seg ? g.B1 : g.B0) + (size_t)nxt.pn * tstepB : cB;
        for (int t = 0; t < nt; t += 2) {
            const bool last = (t == nt - 2);
            const char* a1 = cA + (size_t)(t + 1) * kstep;
            const char* a2 = last ? nA : cA + (size_t)(t + 2) * kstep; const char* b2 = last ? nB : cB + (size_t)(t + 2) * kstep;
            const char* a3 = a2 + kstep; const char* b3 = b2 + kstep;
            PG8_LDB(B0, 0, 0); PG8_LDB(B1, 0, 1); PG8_SCHED; PG8_LDA(At, 0, 0); PG8_STAGE(PG8_SA(1, 1), a1 + hstepA, voffA);
            PG8_WAIT_V(8); PG8_WAIT_L(0); PG8_BAR; PG8_MMA(0, 0, At, B0); PG8_MMA(0, 1, At, B1); PG8_BAR; PG8_SCHED;
            PG8_LDA(At, 0, 1); PG8_STAGE(PG8_SB(0, 0), b2, voffB); PG8_STAGE(PG8_SB(0, 1), b2 + hstepB, voffB); PG8_STAGE(PG8_SA(0, 0), a2, voffA);
            PG8_WAIT_V(8); PG8_WAIT_L(0); PG8_BAR; PG8_MMA(1, 0, At, B0); PG8_MMA(1, 1, At, B1); PG8_BAR; PG8_SCHED;
            PG8_LDB(B0, 1, 0); PG8_LDB(B1, 1, 1); PG8_SCHED; PG8_LDA(At, 1, 0); PG8_STAGE(PG8_SA(0, 1), a2 + hstepA, voffA);
            PG8_WAIT_V(8); PG8_WAIT_L(0); PG8_BAR; PG8_MMA(0, 0, At, B0); PG8_MMA(0, 1, At, B1); PG8_BAR; PG8_SCHED;
            PG8_LDA(At, 1, 1); PG8_STAGE(PG8_SB(1, 0), b3, voffB); PG8_STAGE(PG8_SB(1, 1), b3 + hstepB, voffB); PG8_STAGE(PG8_SA(1, 0), a3, voffA);
            PG8_WAIT_V(8); PG8_WAIT_L(0); PG8_BAR; PG8_MMA(1, 0, At, B0); PG8_MMA(1, 1, At, B1); PG8_BAR; PG8_SCHED;
        }
        if (wr == 0) PG8_BAR;
        const bool keep = E(acc, cur, wr, wc, fr, fq);
        if (!has_next) break;
        if (!keep) {
#pragma unroll
            for (int a = 0; a < 2; ++a)
#pragma unroll
                for (int b = 0; b < 2; ++b)
#pragma unroll
                    for (int m = 0; m < 4; ++m)
#pragma unroll
                        for (int n = 0; n < 2; ++n) acc[a][b][m][n] = (f32x4){0.f, 0.f, 0.f, 0.f};
        }
        cur = nxt; cA = nA; cB = nB; ++ui;
        if (wr == 1) PG8_BAR;
    }
    PG8_WAIT_V(0);
    PG8_BAR;
#undef PG8_SA
#undef PG8_SB
#undef PG8_STAGE
#undef PG8_LDA
#undef PG8_LDB
#undef PG8_MMA
#undef PG8_WAIT_V
#undef PG8_WAIT_L
#undef PG8_BAR
#undef PG8_SCHED
}
}

using pg8::Unit;
__device__ __forceinline__ float rstd_of(const float* ss, int m) { return __builtin_amdgcn_rsqf(ss[m] * (1.0f / D) + EPS); }

struct EpiGU {
    bf16_t* act; const float* ss; const float* cb;
    __device__ __forceinline__ bool operator()(f32x4 (&acc)[2][2][4][2], const Unit& u, int wr, int wc, int fr, int fq) const {
        const int b = u.pm >> 3;
        const float* cbp = cb + b * NGU + u.pn * 256 + wc * 32 + 8 * fq;
        f32x4 cg[2], cu[2];
#pragma unroll
        for (int n = 0; n < 2; ++n) { cg[n] = *(const f32x4*)(cbp + 4 * n); cu[n] = *(const f32x4*)(cbp + 128 + 4 * n); }
#pragma unroll
        for (int ai = 0; ai < 2; ++ai)
#pragma unroll
            for (int m = 0; m < 4; ++m) {
                const int row = u.pm * 256 + ai * 128 + wr * 64 + m * 16 + fr; const float rs = rstd_of(ss, row);
                unsigned w[4];
#pragma unroll
                for (int n = 0; n < 2; ++n) { const f32x4 gv = acc[ai][0][m][n] * rs + cg[n], uv = acc[ai][1][m][n] * rs + cu[n]; float o[4];
#pragma unroll
                    for (int i = 0; i < 4; ++i) o[i] = gv[i] * uv[i] * fsigmoid(gv[i]);
                    w[2 * n] = cvt_pk_bf16(o[0], o[1]); w[2 * n + 1] = cvt_pk_bf16(o[2], o[3]); }
                *(u32x4*)(act + (size_t)row * FF + u.pn * 128 + wc * 32 + 8 * fq) = (u32x4){w[0], w[1], w[2], w[3]};
            }
        return false;
    }
};
template <bool NORM> struct EpiRes {
    const float* resid; float* hout; const float* ga; const float* gn; const float* sc; bf16_t* xn; float* ssq; float gscale;
    __device__ __forceinline__ bool operator()(f32x4 (&acc)[2][2][4][2], const Unit& u, int wr, int wc, int fr, int fq) const {
        const int b = u.pm >> 3; constexpr bool donorm = NORM;
        f32x4 gav[2][2], gsv[2][2];
#pragma unroll
        for (int bj = 0; bj < 2; ++bj)
#pragma unroll
            for (int n = 0; n < 2; ++n) { const int c = u.pn * 256 + bj * 128 + wc * 32 + 8 * fq + 4 * n;
                gav[bj][n] = *(const f32x4*)(ga + b * NMOD + c) * gscale;
                if constexpr (NORM) gsv[bj][n] = *(const f32x4*)(gn + c) * (*(const f32x4*)(sc + b * NMOD + c) + 1.0f); }
#pragma unroll
        for (int ai = 0; ai < 2; ++ai)
#pragma unroll
            for (int m = 0; m < 4; ++m) {
                const int row = u.pm * 256 + ai * 128 + wr * 64 + m * 16 + fr; float s = 0.f;
#pragma unroll
                for (int bj = 0; bj < 2; ++bj) { const size_t off = (size_t)row * D + u.pn * 256 + bj * 128 + wc * 32 + 8 * fq;
                    const f32x4 r0 = *(const f32x4*)(resid + off), r1 = *(const f32x4*)(resid + off + 4);
                    const f32x4 v0 = r0 + gav[bj][0] * acc[ai][bj][m][0], v1 = r1 + gav[bj][1] * acc[ai][bj][m][1];
                    *(f32x4*)(hout + off) = v0; *(f32x4*)(hout + off + 4) = v1;
                    if constexpr (NORM) { const f32x4 a0 = v0 * gsv[bj][0], a1 = v1 * gsv[bj][1];
                        *(u32x4*)(xn + off) = (u32x4){cvt_pk_bf16(a0[0], a0[1]), cvt_pk_bf16(a0[2], a0[3]), cvt_pk_bf16(a1[0], a1[1]), cvt_pk_bf16(a1[2], a1[3])};
                        s += (v0[0] * v0[0] + v0[1] * v0[1]) + (v0[2] * v0[2] + v0[3] * v0[3]) + (v1[0] * v1[0] + v1[1] * v1[1]) + (v1[2] * v1[2] + v1[3] * v1[3]); } }
                if constexpr (NORM) { s += __shfl_xor(s, 16); s += __shfl_xor(s, 32); if (fq == 0) atomicAdd(ssq + row, s); }
                if (m & 1) asm volatile("" ::: "memory");
            }
        return false;
    }
};
struct EpiWin {
    bf16_t* P; const float* ss; const float* cb;
    __device__ __forceinline__ bool operator()(f32x4 (&acc)[2][2][4][2], const Unit& u, int wr, int wc, int fr, int fq) const {
        const int b = u.pm >> 3; const int kind = u.pn < 4 ? 0 : (u.pn < 7 ? 1 : 2);
        f32x4 cv[2][2];
#pragma unroll
        for (int bj = 0; bj < 2; ++bj)
#pragma unroll
            for (int n = 0; n < 2; ++n) cv[bj][n] = *(const f32x4*)(cb + b * NIN + u.pn * 256 + bj * 128 + wc * 32 + 8 * fq + 4 * n);
#pragma unroll
        for (int ai = 0; ai < 2; ++ai)
#pragma unroll
            for (int m = 0; m < 4; ++m) {
                const int row = u.pm * 256 + ai * 128 + wr * 64 + m * 16 + fr; const float rs = rstd_of(ss, row);
#pragma unroll
                for (int bj = 0; bj < 2; ++bj) { unsigned w[4];
#pragma unroll
                    for (int n = 0; n < 2; ++n) { f32x4 v = acc[ai][bj][m][n] * rs + cv[bj][n];
                        if (kind == 0) { v[0] = fgelu_tanh(v[0]); v[1] = fgelu_tanh(v[1]); v[2] = fgelu_tanh(v[2]); v[3] = fgelu_tanh(v[3]); }
                        else if (kind == 2) { v[0] = fsigmoid(v[0]); v[1] = fsigmoid(v[1]); v[2] = fsigmoid(v[2]); v[3] = fsigmoid(v[3]); }
                        w[2 * n] = cvt_pk_bf16(v[0], v[1]); w[2 * n + 1] = cvt_pk_bf16(v[2], v[3]); }
                    *(u32x4*)(P + (size_t)row * NIN + u.pn * 256 + bj * 128 + wc * 32 + 8 * fq) = (u32x4){w[0], w[1], w[2], w[3]}; }
            }
        return false;
    }
};
struct EpiBranch {
    const bf16_t* P; bf16_t* merged;
    __device__ __forceinline__ bool operator()(f32x4 (&acc)[2][2][4][2], const Unit& u, int wr, int wc, int fr, int fq) const {
#pragma unroll
        for (int ai = 0; ai < 2; ++ai)
#pragma unroll
            for (int m = 0; m < 4; ++m) {
                const int row = u.pm * 256 + ai * 128 + wr * 64 + m * 16 + fr;
#pragma unroll
                for (int bj = 0; bj < 2; ++bj) { const int c = u.pn * 256 + bj * 128 + wc * 32 + 8 * fq;
                    const u32x4 gb = *(const u32x4*)(P + (size_t)row * NIN + PC_GB + c);
                    float sb[8] = {bflo(gb[0]), bfhi(gb[0]), bflo(gb[1]), bfhi(gb[1]), bflo(gb[2]), bfhi(gb[2]), bflo(gb[3]), bfhi(gb[3])};
                    if (u.seg == 0) {
                        const u32x4 gaw = *(const u32x4*)(P + (size_t)row * NIN + PC_GA + c);
                        const float sa[8] = {bflo(gaw[0]), bfhi(gaw[0]), bflo(gaw[1]), bfhi(gaw[1]), bflo(gaw[2]), bfhi(gaw[2]), bflo(gaw[3]), bfhi(gaw[3])};
#pragma unroll
                        for (int i = 0; i < 4; ++i) { acc[ai][bj][m][0][i] *= sa[i] * __builtin_amdgcn_rcpf(fmaxf(sb[i], 1e-30f)); acc[ai][bj][m][1][i] *= sa[4 + i] * __builtin_amdgcn_rcpf(fmaxf(sb[4 + i], 1e-30f)); }
                    } else {
                        const f32x4 a0 = acc[ai][bj][m][0], a1 = acc[ai][bj][m][1];
                        *(u32x4*)(merged + (size_t)row * D + c) = (u32x4){cvt_pk_bf16(a0[0] * sb[0], a0[1] * sb[1]), cvt_pk_bf16(a0[2] * sb[2], a0[3] * sb[3]), cvt_pk_bf16(a1[0] * sb[4], a1[1] * sb[5]), cvt_pk_bf16(a1[2] * sb[6], a1[3] * sb[7])};
                    } }
                if (m & 1) asm volatile("" ::: "memory");
            }
        return u.seg == 0;
    }
};

#define XB_TMO      128
#define XB_XCNT(j)  (256  + 64 * (j))
#define XB_XSUB(j)  (1280 + 64 * (j))
#define XB_XGEN(j)  (2304 + 64 * (j))
#define XB_TOP      3328
#define XB_TOPGEN   3392
#define XCD_BAR_WORDS 3456
#define XB_SPIN_CAP (1u << 18)

__device__ __forceinline__ unsigned xb_ld(unsigned* p)              { return __hip_atomic_load(p, __ATOMIC_RELAXED, __HIP_MEMORY_SCOPE_AGENT); }
__device__ __forceinline__ unsigned xb_add(unsigned* p, unsigned v) { return __hip_atomic_fetch_add(p, v, __ATOMIC_RELAXED, __HIP_MEMORY_SCOPE_AGENT); }
__device__ __forceinline__ unsigned xb_xcc_id() { return (unsigned)__builtin_amdgcn_s_getreg((3 << 11) | 20) & 0xFu; }
#define XB_SPIN(cond, bar) do { unsigned _sp = 0; while (cond) { __builtin_amdgcn_s_sleep(1); \
    if ((++_sp & 255u) == 0u) { if (xb_ld(&(bar)[XB_TMO])) break; if (_sp > XB_SPIN_CAP) { atomicAdd(&(bar)[XB_TMO], 1u); break; } } } } while (0)

struct XcdBarrier {
    unsigned* bar; unsigned x;
    volatile LAS unsigned* st;
};

__device__ __forceinline__ XcdBarrier xcd_barrier_post(unsigned* bar, volatile LAS unsigned* st) {
    XcdBarrier b; b.bar = bar; b.x = xb_xcc_id(); b.st = st;
    if (threadIdx.x == 0) (void)xb_add(&bar[XB_XCNT(b.x)], 1u);
    return b;
}
__device__ __forceinline__ void xcd_barrier_complete(unsigned* bar, unsigned x, unsigned& nloc, unsigned& nx) {
    const unsigned G = gridDim.x * gridDim.y * gridDim.z;
    unsigned sum, cnt, mine, sp = 0u;
    for (;;) {
        sum = 0u; cnt = 0u; mine = 0u;
#pragma unroll
        for (unsigned j = 0; j < 16; ++j) { const unsigned c = xb_ld(&bar[XB_XCNT(j)]); sum += c; cnt += (c > 0u) ? 1u : 0u; mine = (j == x) ? c : mine; }
        if (sum == G) break;
        __builtin_amdgcn_s_sleep(1);
        if ((++sp & 255u) == 0u) { if (xb_ld(&bar[XB_TMO])) break; if (sp > XB_SPIN_CAP) { atomicAdd(&bar[XB_TMO], 1u); break; } }
    }
    nloc = mine > 0u ? mine : 1u; nx = cnt > 0u ? cnt : 1u;
}

__device__ __forceinline__ void xcd_barrier(const XcdBarrier& b) {
    asm volatile("s_waitcnt vmcnt(0)" ::: "memory");
    __syncthreads();
    if (threadIdx.x == 0) {
        unsigned* bar = b.bar;
        __builtin_amdgcn_s_waitcnt(0);
        unsigned nloc = b.st[0], nx = b.st[1];
        if (nloc == 0u) { xcd_barrier_complete(bar, b.x, nloc, nx); b.st[0] = nloc; b.st[1] = nx; }
        const unsigned old = xb_add(&bar[XB_XSUB(b.x)], 1u);
        const unsigned gen = old / nloc;
        if (old + 1u == (gen + 1u) * nloc) {
            __builtin_amdgcn_fence(__ATOMIC_RELEASE, "agent");
            asm volatile("s_waitcnt vmcnt(0)" ::: "memory");
            const unsigned og = xb_add(&bar[XB_TOP], 1u);
            const unsigned tg = og / nx;
            if (og + 1u == (tg + 1u) * nx) xb_add(&bar[XB_TOPGEN], 1u);
            else XB_SPIN(xb_ld(&bar[XB_TOPGEN]) == tg, bar);
            __builtin_amdgcn_fence(__ATOMIC_ACQUIRE, "agent");
            xb_add(&bar[XB_XGEN(b.x)], 1u);
            asm volatile("s_waitcnt vmcnt(0)" ::: "memory");
        } else {
            XB_SPIN(xb_ld(&bar[XB_XGEN(b.x)]) == gen, bar);
            __builtin_amdgcn_fence(__ATOMIC_ACQUIRE, "agent");
            asm volatile("s_waitcnt vmcnt(0)" ::: "memory");
        }
    }
    __syncthreads();
}

constexpr int NWAVES = 8;
constexpr int RING_OFF = 0, RING_BYTES = 131072;
constexpr int LDSCTL_OFF = RING_BYTES, MISC_OFF = LDSCTL_OFF + 320;
constexpr int LDS_BYTES = 147456;
static_assert(MISC_OFF + 128 <= LDS_BYTES, "LDS map");

struct Frame {
    LAS unsigned char* lds;
    volatile LAS unsigned* MISC;
    int tid, lane, wave;
    int vcu, G;
};
struct Args { const float* in[24]; float* out; unsigned char* ws; int ph_lo, ph_hi, li, pad; };

__device__ __forceinline__ float wave_sum(float v) {
#pragma unroll
    for (int o = 1; o < 64; o <<= 1) v += __shfl_xor(v, o);
    return v;
}
__device__ __forceinline__ void p0_mods_item(const Frame& F, const float* c, const float* w_ada, const float* b_ada, float* mods, int item, bool fill) {
    LAS float* sc = (LAS float*)(F.lds + RING_OFF);
    LAS float* red = (LAS float*)(F.lds + RING_OFF + 65536);
    if (fill) { for (int i = F.tid; i < BATCH * D; i += NWAVES * 64) { const float v = c[i]; sc[i] = v * fsigmoid(v); } __syncthreads(); }
    const int j = item * 64 + F.lane, k0 = F.wave * 128;
    float acc[BATCH];
#pragma unroll
    for (int b = 0; b < BATCH; ++b) acc[b] = 0.f;
#pragma unroll 4
    for (int k = k0; k < k0 + 128; ++k) { const float wv = w_ada[(size_t)k * NMOD + j];
#pragma unroll
        for (int b = 0; b < BATCH; ++b) acc[b] += sc[b * D + k] * wv; }
#pragma unroll
    for (int b = 0; b < BATCH; ++b) red[(F.wave * BATCH + b) * 64 + F.lane] = acc[b];
    __syncthreads();
    for (int i = F.tid; i < BATCH * 64; i += NWAVES * 64) { const int b = i >> 6, l = i & 63; float s = 0.f;
#pragma unroll
        for (int w = 0; w < NWAVES; ++w) s += red[(w * BATCH + b) * 64 + l];
        mods[b * NMOD + item * 64 + l] = s + b_ada[item * 64 + l]; }
    __syncthreads();
}
__device__ __forceinline__ void p0_transpose_item(const float* W, int K, int N, bf16_t* WT, int gu, LAS float* scr, int item, int lane) {
    const int nblk = N / 32, kb = item / nblk, nb = item % nblk, k0 = 64 * kb, n0 = 32 * nb;
#pragma unroll 8
    for (int i = 0; i < 32; ++i) { const int kk = 2 * i + (lane >> 5); scr[kk * 33 + (lane & 31)] = W[(size_t)(k0 + kk) * N + n0 + (lane & 31)]; }
    LDS_WAIT(); asm volatile("" ::: "memory");
    const int c = lane & 7;
    const int r0 = gu ? (256 * (n0 >> 7) + (n0 & 127) + 128 * (gu - 1)) : n0;
#pragma unroll
    for (int j = 0; j < 4; ++j) { const int n = (lane >> 3) + 8 * j; const LAS float* s = scr + (8 * c) * 33 + n;
        u32x4 o; o.x = pk2(s[0 * 33], s[1 * 33]); o.y = pk2(s[2 * 33], s[3 * 33]); o.z = pk2(s[4 * 33], s[5 * 33]); o.w = pk2(s[6 * 33], s[7 * 33]);
        *(GAS u32x4*)(WT + (size_t)(r0 + n) * K + k0 + 8 * c) = o; }
    LDS_WAIT(); asm volatile("" ::: "memory");
}
struct WsPtrs {
    float *mods, *cb1, *cb2, *cb3, *ss1, *ss2, *ss3;
    bf16_t *WGU1, *WD1, *WIN, *WA, *WB, *WO, *WGU2, *WD2, *WSP, *XN, *MIX, *MERGED, *ACT, *P;
};
__device__ __forceinline__ void p0_prologue(const Frame& F, const Args& a, const WsPtrs& w) {
    if (F.vcu < NMOD / 64) p0_mods_item(F, a.in[1], a.in[2], a.in[3], w.mods, F.vcu, true);
    LAS float* scr = (LAS float*)(F.lds + RING_OFF + F.wave * 16384);
    const int gw = F.vcu * NWAVES + F.wave, NGW = F.G * NWAVES;
    constexpr int I_G = (D / 64) * (FF / 32), I_D = (FF / 64) * (D / 32), I_IN = (D / 64) * (NIN / 32), I_AB = (DA / 64) * (D / 32), I_O = (D / 64) * (D / 32);
    constexpr int NITEMS = 4 * I_G + 2 * I_D + I_IN + 2 * I_AB + I_O;
    for (int it = gw; it < NITEMS; it += NGW) {
        int r = it;
        if (r < I_G) { p0_transpose_item(a.in[5], D, FF, w.WGU1, 1, scr, r, F.lane); continue; } r -= I_G;
        if (r < I_G) { p0_transpose_item(a.in[6], D, FF, w.WGU1, 2, scr, r, F.lane); continue; } r -= I_G;
        if (r < I_D) { p0_transpose_item(a.in[7], FF, D, w.WD1, 0, scr, r, F.lane); continue; } r -= I_D;
        if (r < I_IN) { p0_transpose_item(a.in[9], D, NIN, w.WIN, 0, scr, r, F.lane); continue; } r -= I_IN;
        if (r < I_AB) { p0_transpose_item(a.in[17], DA, D, w.WA, 0, scr, r, F.lane); continue; } r -= I_AB;
        if (r < I_AB) { p0_transpose_item(a.in[18], DB, D, w.WB, 0, scr, r, F.lane); continue; } r -= I_AB;
        if (r < I_O) { p0_transpose_item(a.in[19], D, D, w.WO, 0, scr, r, F.lane); continue; } r -= I_O;
        if (r < I_G) { p0_transpose_item(a.in[21], D, FF, w.WGU2, 1, scr, r, F.lane); continue; } r -= I_G;
        if (r < I_G) { p0_transpose_item(a.in[22], D, FF, w.WGU2, 2, scr, r, F.lane); continue; } r -= I_G;
        p0_transpose_item(a.in[23], FF, D, w.WD2, 0, scr, r, F.lane);
    }
    for (int i = (F.vcu * NWAVES * 64 + F.tid); i < NG * CHUNK * CHUNK; i += F.G * NWAVES * 64) { const int s = i & 127, t = (i >> 7) & 127; w.WSP[i] = (bf16_t)f2bf(s <= t ? a.in[12][i] : 0.f); }
}
__device__ __forceinline__ void p1_cb_rows(const Frame& F, const float* mods, int which, const bf16_t* Wt, int N, float* cb, int gw, int NGW) {
    for (int r = gw; r < N; r += NGW) {
        const u32x4 w0 = *(const u32x4*)(Wt + (size_t)r * D + F.lane * 16), w1 = *(const u32x4*)(Wt + (size_t)r * D + F.lane * 16 + 8);
        const float wv[16] = {bflo(w0[0]), bfhi(w0[0]), bflo(w0[1]), bfhi(w0[1]), bflo(w0[2]), bfhi(w0[2]), bflo(w0[3]), bfhi(w0[3]),
                              bflo(w1[0]), bfhi(w1[0]), bflo(w1[1]), bfhi(w1[1]), bflo(w1[2]), bfhi(w1[2]), bflo(w1[3]), bfhi(w1[3])};
        float res = 0.f;
#pragma unroll 4
        for (int b = 0; b < BATCH; ++b) { const float* sh = mods + b * NMOD + 3 * which * D + F.lane * 16; float s = 0.f;
#pragma unroll
            for (int q = 0; q < 4; ++q) { const f32x4 v = *(const f32x4*)(sh + 4 * q); s += v[0] * wv[4 * q] + v[1] * wv[4 * q + 1] + v[2] * wv[4 * q + 2] + v[3] * wv[4 * q + 3]; }
            s = wave_sum(s); if (F.lane == b) res = s; }
        if (F.lane < BATCH) cb[F.lane * N + r] = res;
    }
}
__device__ __forceinline__ void p1_phase(const Frame& F, const Args& a, const WsPtrs& w) {
    const int gw = F.vcu * NWAVES + F.wave, NGW = F.G * NWAVES;
    for (int blk = gw; blk < M / 16; blk += NGW) {
        const int m0 = blk * 16, b = m0 >> 11;
        f32x4 gsv[2][2];
#pragma unroll
        for (int j = 0; j < 2; ++j)
#pragma unroll
            for (int h = 0; h < 2; ++h) { const int k = j * 512 + F.lane * 8 + h * 4; gsv[j][h] = *(const f32x4*)(a.in[4] + k) * (*(const f32x4*)(w.mods + b * NMOD + 1 * D + k) + 1.0f); }
        for (int r = 0; r < 16; ++r) { const float* xr = a.in[0] + (size_t)(m0 + r) * D; float s = 0.f;
#pragma unroll
            for (int j = 0; j < 2; ++j) { const int k = j * 512 + F.lane * 8;
                const f32x4 v0 = *(const f32x4*)(xr + k), v1 = *(const f32x4*)(xr + k + 4);
                s += (v0[0] * v0[0] + v0[1] * v0[1]) + (v0[2] * v0[2] + v0[3] * v0[3]) + (v1[0] * v1[0] + v1[1] * v1[1]) + (v1[2] * v1[2] + v1[3] * v1[3]);
                const f32x4 a0 = v0 * gsv[j][0], a1 = v1 * gsv[j][1];
                *(u32x4*)(w.XN + (size_t)(m0 + r) * D + k) = (u32x4){cvt_pk_bf16(a0[0], a0[1]), cvt_pk_bf16(a0[2], a0[3]), cvt_pk_bf16(a1[0], a1[1]), cvt_pk_bf16(a1[2], a1[3])}; }
            s = wave_sum(s); if (F.lane == 0) w.ss1[m0 + r] = s; }
    }
    p1_cb_rows(F, w.mods, 0, w.WGU1, NGU, w.cb1, gw, NGW);
    p1_cb_rows(F, w.mods, 1, w.WIN, NIN, w.cb2, gw, NGW);
    p1_cb_rows(F, w.mods, 2, w.WGU2, NGU, w.cb3, gw, NGW);
}

__global__ void k_vln(const bf16_t* P, const float* g, const float* bta, bf16_t* vn) {
    const int m = (blockIdx.x * blockDim.x + threadIdx.x) >> 6, lane = threadIdx.x & 63;
    if (m >= M) return;
    float v[8], s = 0.f;
    for (int i = 0; i < 8; ++i) { v[i] = bf2f(P[(size_t)m * NIN + PC_V + i * 64 + lane]); s += v[i]; }
    for (int o = 1; o < 64; o <<= 1) s += __shfl_xor(s, o);
    const float mu = s * (1.0f / DA); float q = 0.f;
    for (int i = 0; i < 8; ++i) { v[i] -= mu; q += v[i] * v[i]; }
    for (int o = 1; o < 64; o <<= 1) q += __shfl_xor(q, o);
    const float rs = rsqrtf(q * (1.0f / DA) + EPS);
    for (int i = 0; i < 8; ++i) { const int c = i * 64 + lane; vn[(size_t)m * DA + c] = f2bf(v[i] * rs * g[c] + bta[c]); }
}
__global__ void k_sgu(const bf16_t* P, const bf16_t* vn, const bf16_t* wsp, const float* bsp, bf16_t* mix) {
    const int ch = threadIdx.x + (blockIdx.x & 1) * 256, m = blockIdx.x >> 1;
    const int t = m & 127, g = ch >> 7, m0 = m - t;
    float z = 0.f;
    for (int s = 0; s <= t; ++s) z += bf2f(wsp[(g * 128 + t) * 128 + s]) * bf2f(vn[(size_t)(m0 + s) * DA + ch]);
    z += bsp[g * 128 + t];
    mix[(size_t)m * D + ch] = f2bf(bf2f(P[(size_t)m * NIN + PC_U + ch]) * z);
}
__global__ __launch_bounds__(128) void k_attn(const bf16_t* P, const float* gq, const float* gk, const float* sinks, bf16_t* mix) {
    const int i = threadIdx.x, hq = blockIdx.x & 7, n = (blockIdx.x >> 3) & 15, b = blockIdx.x >> 7, h = hq >> 2;
    const int m = b * SEQ + n * 128 + i;
    float q[64], o[64]; float s2 = 0.f;
    for (int d = 0; d < 64; ++d) { q[d] = bf2f(P[(size_t)m * NIN + PC_Q + hq * 64 + d]); s2 += q[d] * q[d]; o[d] = 0.f; }
    const float qs = rsqrtf(s2 * (1.0f / 64) + EPS) * 0.125f;
    for (int d = 0; d < 64; ++d) q[d] *= qs * gq[d];
    const float sink = sinks[hq];
    float mx = sink, l = 1.0f;
    for (int dj = 127; dj >= 0; --dj) {
        const int kp = n * 128 + i - dj; if (kp < 0) continue;
        const bf16_t* kr = P + (size_t)(b * SEQ + kp) * NIN + PC_K + h * 64;
        float kk[64], k2 = 0.f;
        for (int d = 0; d < 64; ++d) { kk[d] = bf2f(kr[d]); k2 += kk[d] * kk[d]; }
        const float ks = rsqrtf(k2 * (1.0f / 64) + EPS); float sc = 0.f;
        for (int d = 0; d < 64; ++d) sc += q[d] * kk[d] * gk[d];
        sc *= ks;
        const float nm = fmaxf(mx, sc), f = __expf(mx - nm), p = __expf(sc - nm);
        const bf16_t* vr = P + (size_t)(b * SEQ + kp) * NIN + PC_VV + h * 64;
        for (int d = 0; d < 64; ++d) o[d] = o[d] * f + p * bf2f(vr[d]);
        l = l * f + p; mx = nm;
    }
    const float il = 1.0f / l;
    for (int d = 0; d < 64; ++d) mix[(size_t)m * D + 512 + hq * 64 + d] = f2bf(o[d] * il);
}


typedef short s16x4 __attribute__((ext_vector_type(4)));
typedef short v4i16_t __attribute__((ext_vector_type(4)));
__device__ __forceinline__ s16x4 vtr(const LAS unsigned char* p) { return __builtin_bit_cast(s16x4, __builtin_amdgcn_ds_read_tr16_b64_v4i16((LAS v4i16_t*)p)); }
__device__ __forceinline__ bf16x8 cat4(s16x4 a, s16x4 b) { return (bf16x8){a[0], a[1], a[2], a[3], b[0], b[1], b[2], b[3]}; }
__device__ __forceinline__ void unpack8(const u32x4 v, float (&f)[8]) { f[0] = bflo(v[0]); f[1] = bfhi(v[0]); f[2] = bflo(v[1]); f[3] = bfhi(v[1]); f[4] = bflo(v[2]); f[5] = bfhi(v[2]); f[6] = bflo(v[3]); f[7] = bfhi(v[3]); }

constexpr int KP = 144, VP = 144;
constexpr int ATT_K_OFF = 0, ATT_V_OFF = 256 * KP;
constexpr int NP = 272;
static_assert(ATT_V_OFF + 256 * VP <= RING_BYTES && 128 * NP <= RING_BYTES, "mixer LDS");

__device__ __forceinline__ void attn_unit(const Frame& F, const bf16_t* P, bf16_t* MIX, const float* gq, const float* gk, const float* sinks, int b, int n, int hq) {
    const int h = hq >> 2, lane = F.lane, w = F.wave, r = lane & 15, g = lane >> 4;
    LAS unsigned char* Kt = F.lds + RING_OFF + ATT_K_OFF; LAS unsigned char* Vt = F.lds + RING_OFF + ATT_V_OFF;
    {
        const int ch = F.tid & 7;
        const f32x4 gk0 = *(const f32x4*)(gk + ch * 8), gk1 = *(const f32x4*)(gk + ch * 8 + 4);
#pragma unroll
        for (int it = 0; it < 4; ++it) {
            const int j = (F.tid >> 3) + 64 * it, kp = (n - 1) * 128 + j;
            u32x4 kv = (u32x4){0u, 0u, 0u, 0u}, vv = (u32x4){0u, 0u, 0u, 0u};
            if (kp >= 0) { const bf16_t* rowp = P + (size_t)(b * SEQ + kp) * NIN; kv = *(const u32x4*)(rowp + PC_K + h * 64 + ch * 8); vv = *(const u32x4*)(rowp + PC_VV + h * 64 + ch * 8); }
            float kf[8]; unpack8(kv, kf);
            float ss = (kf[0] * kf[0] + kf[1] * kf[1]) + (kf[2] * kf[2] + kf[3] * kf[3]) + (kf[4] * kf[4] + kf[5] * kf[5]) + (kf[6] * kf[6] + kf[7] * kf[7]);
            ss += __shfl_xor(ss, 1); ss += __shfl_xor(ss, 2); ss += __shfl_xor(ss, 4);
            const float rs = __builtin_amdgcn_rsqf(ss * (1.0f / HD) + EPS);
            const u32x4 kn = (u32x4){cvt_pk_bf16(kf[0] * rs * gk0[0], kf[1] * rs * gk0[1]), cvt_pk_bf16(kf[2] * rs * gk0[2], kf[3] * rs * gk0[3]),
                                     cvt_pk_bf16(kf[4] * rs * gk1[0], kf[5] * rs * gk1[1]), cvt_pk_bf16(kf[6] * rs * gk1[2], kf[7] * rs * gk1[3])};
            *(LAS u32x4*)(Kt + j * KP + ch * 16) = kn;
            *(LAS u32x4*)(Vt + j * VP + ch * 16) = vv;
        }
    }
    const int qrow = b * SEQ + n * 128 + 16 * w + r;
    bf16x8 qa0, qa1;
    {
        const bf16_t* qp = P + (size_t)qrow * NIN + PC_Q + hq * 64;
        const u32x4 q0 = *(const u32x4*)(qp + 8 * g), q1 = *(const u32x4*)(qp + 32 + 8 * g);
        float a[8], c[8]; unpack8(q0, a); unpack8(q1, c);
        float ss = 0.f;
#pragma unroll
        for (int i = 0; i < 8; ++i) ss += a[i] * a[i] + c[i] * c[i];
        ss += __shfl_xor(ss, 16); ss += __shfl_xor(ss, 32);
        const float qs = __builtin_amdgcn_rsqf(ss * (1.0f / HD) + EPS) * (0.125f * LOG2E);
        const f32x4 ga0 = *(const f32x4*)(gq + 8 * g), ga1 = *(const f32x4*)(gq + 8 * g + 4), gc0 = *(const f32x4*)(gq + 32 + 8 * g), gc1 = *(const f32x4*)(gq + 32 + 8 * g + 4);
        const u32x4 p0 = (u32x4){cvt_pk_bf16(a[0] * qs * ga0[0], a[1] * qs * ga0[1]), cvt_pk_bf16(a[2] * qs * ga0[2], a[3] * qs * ga0[3]), cvt_pk_bf16(a[4] * qs * ga1[0], a[5] * qs * ga1[1]), cvt_pk_bf16(a[6] * qs * ga1[2], a[7] * qs * ga1[3])};
        const u32x4 p1 = (u32x4){cvt_pk_bf16(c[0] * qs * gc0[0], c[1] * qs * gc0[1]), cvt_pk_bf16(c[2] * qs * gc0[2], c[3] * qs * gc0[3]), cvt_pk_bf16(c[4] * qs * gc1[0], c[5] * qs * gc1[1]), cvt_pk_bf16(c[6] * qs * gc1[2], c[7] * qs * gc1[3])};
        qa0 = __builtin_bit_cast(bf16x8, p0); qa1 = __builtin_bit_cast(bf16x8, p1);
    }
    __syncthreads();
    f32x4 sacc[10];
#pragma unroll
    for (int fp = 0; fp < 10; ++fp) {
        const int f = (w + fp) < 16 ? (w + fp) : 15;
        const LAS unsigned char* kr = Kt + (16 * f + r) * KP + g * 16;
        const bf16x8 k0 = *(const LAS bf16x8*)kr, k1 = *(const LAS bf16x8*)(kr + 64);
        sacc[fp] = __builtin_amdgcn_mfma_f32_16x16x32_bf16(k0, qa0, (f32x4){0.f, 0.f, 0.f, 0.f}, 0, 0, 0);
        sacc[fp] = __builtin_amdgcn_mfma_f32_16x16x32_bf16(k1, qa1, sacc[fp], 0, 0, 0);
    }
    const float sink2 = sinks[hq] * LOG2E;
    float mx = sink2;
#pragma unroll
    for (int fp = 0; fp < 10; ++fp)
#pragma unroll
        for (int e = 0; e < 4; ++e) { const int rel = 16 * fp + 4 * g + e - r; const bool valid = (rel >= 1) && (rel <= 128) && (n > 0 || (16 * (w + fp) + 4 * g + e) >= 128);
            const float t = valid ? sacc[fp][e] : -INFINITY; sacc[fp][e] = t; mx = fmaxf(mx, t); }
    mx = fmaxf(mx, __shfl_xor(mx, 16)); mx = fmaxf(mx, __shfl_xor(mx, 32));
    float l = 0.f;
#pragma unroll
    for (int fp = 0; fp < 10; ++fp)
#pragma unroll
        for (int e = 0; e < 4; ++e) { const float p = __builtin_amdgcn_exp2f(sacc[fp][e] - mx); sacc[fp][e] = p; l += p; }
    l += __shfl_xor(l, 16); l += __shfl_xor(l, 32);
    l += __builtin_amdgcn_exp2f(sink2 - mx);
    const float inv = 1.0f / l;
    f32x4 oacc[4];
#pragma unroll
    for (int df = 0; df < 4; ++df) oacc[df] = (f32x4){0.f, 0.f, 0.f, 0.f};
    const int q4 = (lane & 15) >> 2, p4 = lane & 3;
#pragma unroll
    for (int s = 0; s < 5; ++s) {
        const u32x4 pw = (u32x4){cvt_pk_bf16(sacc[2 * s][0], sacc[2 * s][1]), cvt_pk_bf16(sacc[2 * s][2], sacc[2 * s][3]), cvt_pk_bf16(sacc[2 * s + 1][0], sacc[2 * s + 1][1]), cvt_pk_bf16(sacc[2 * s + 1][2], sacc[2 * s + 1][3])};
        const bf16x8 pb = __builtin_bit_cast(bf16x8, pw);
        s16x4 vt[2][4];
#pragma unroll
        for (int t = 0; t < 2; ++t) { const int f = (w + 2 * s + t) < 16 ? (w + 2 * s + t) : 15;
            const LAS unsigned char* vr = Vt + (16 * f + 4 * g + q4) * VP + 32 * p4;
#pragma unroll
            for (int df = 0; df < 4; ++df) vt[t][df] = vtr(vr + 8 * df); }
#pragma unroll
        for (int df = 0; df < 4; ++df) oacc[df] = __builtin_amdgcn_mfma_f32_16x16x32_bf16(cat4(vt[0][df], vt[1][df]), pb, oacc[df], 0, 0, 0);
    }
    {
        bf16_t* op = MIX + (size_t)qrow * D + 512 + hq * 64 + 16 * g;
        const u32x4 o0 = (u32x4){cvt_pk_bf16(oacc[0][0] * inv, oacc[0][1] * inv), cvt_pk_bf16(oacc[0][2] * inv, oacc[0][3] * inv), cvt_pk_bf16(oacc[1][0] * inv, oacc[1][1] * inv), cvt_pk_bf16(oacc[1][2] * inv, oacc[1][3] * inv)};
        const u32x4 o1 = (u32x4){cvt_pk_bf16(oacc[2][0] * inv, oacc[2][1] * inv), cvt_pk_bf16(oacc[2][2] * inv, oacc[2][3] * inv), cvt_pk_bf16(oacc[3][0] * inv, oacc[3][1] * inv), cvt_pk_bf16(oacc[3][2] * inv, oacc[3][3] * inv)};
        *(u32x4*)op = o0; *(u32x4*)(op + 8) = o1;
    }
    __syncthreads();
}

__device__ __forceinline__ void sgu_unit(const Frame& F, const bf16_t* P, bf16_t* MIX, const bf16_t* WSP, const float* gln, const float* bln, const float* bsp, int b, int n, int g) {
    const int lane = F.lane, w = F.wave, gq = lane >> 4;
    LAS unsigned char* Vn = F.lds + RING_OFF;
    const int row0 = b * SEQ + n * 128;
    {
        const f32x4 g0 = *(const f32x4*)(gln + lane * 8), g1 = *(const f32x4*)(gln + lane * 8 + 4), b0 = *(const f32x4*)(bln + lane * 8), b1 = *(const f32x4*)(bln + lane * 8 + 4);
#pragma unroll 4
        for (int rr = 0; rr < 16; ++rr) {
            const u32x4 xv = *(const u32x4*)(P + (size_t)(row0 + 16 * w + rr) * NIN + PC_V + lane * 8);
            float x[8]; unpack8(xv, x);
            float s = ((x[0] + x[1]) + (x[2] + x[3])) + ((x[4] + x[5]) + (x[6] + x[7]));
            s = wave_sum(s); const float mu = s * (1.0f / DA);
            float q = 0.f;
#pragma unroll
            for (int i = 0; i < 8; ++i) { x[i] -= mu; q += x[i] * x[i]; }
            q = wave_sum(q); const float rs = __builtin_amdgcn_rsqf(q * (1.0f / DA) + EPS);
            if (gq == g) {
                const u32x4 o = (u32x4){cvt_pk_bf16(x[0] * rs * g0[0] + b0[0], x[1] * rs * g0[1] + b0[1]), cvt_pk_bf16(x[2] * rs * g0[2] + b0[2], x[3] * rs * g0[3] + b0[3]),
                                        cvt_pk_bf16(x[4] * rs * g1[0] + b1[0], x[5] * rs * g1[1] + b1[1]), cvt_pk_bf16(x[6] * rs * g1[2] + b1[2], x[7] * rs * g1[3] + b1[3])};
                *(LAS u32x4*)(Vn + (16 * w + rr) * NP + (lane & 15) * 16) = o;
            }
        }
    }
    __syncthreads();
    f32x4 z[8];
#pragma unroll
    for (int cf = 0; cf < 8; ++cf) z[cf] = (f32x4){0.f, 0.f, 0.f, 0.f};
    const int t = 16 * w + (lane & 15), q4 = (lane & 15) >> 2, p4 = lane & 3;
    const bf16_t* wrow = WSP + (size_t)(g * 128 + t) * 128 + 8 * gq;
    for (int ks = 0; ks <= (w >> 1); ++ks) {
        const bf16x8 wb = *(const bf16x8*)(wrow + 32 * ks);
        s16x4 vt[2][8];
#pragma unroll
        for (int t2 = 0; t2 < 2; ++t2) { const LAS unsigned char* vr = Vn + (32 * ks + 8 * gq + 4 * t2 + q4) * NP + 64 * p4;
#pragma unroll
            for (int cf = 0; cf < 8; ++cf) vt[t2][cf] = vtr(vr + 8 * cf); }
#pragma unroll
        for (int cf = 0; cf < 8; ++cf) z[cf] = __builtin_amdgcn_mfma_f32_16x16x32_bf16(cat4(vt[0][cf], vt[1][cf]), wb, z[cf], 0, 0, 0);
    }
    {
        const float bias = bsp[g * 128 + t];
        const bf16_t* up = P + (size_t)(row0 + t) * NIN + PC_U + g * 128 + 32 * gq;
        bf16_t* op = MIX + (size_t)(row0 + t) * D + g * 128 + 32 * gq;
#pragma unroll
        for (int k = 0; k < 4; ++k) {
            const u32x4 uv = *(const u32x4*)(up + 8 * k); float uf[8]; unpack8(uv, uf);
            const f32x4 za = z[2 * k] + bias, zb = z[2 * k + 1] + bias;
            *(u32x4*)(op + 8 * k) = (u32x4){cvt_pk_bf16(uf[0] * za[0], uf[1] * za[1]), cvt_pk_bf16(uf[2] * za[2], uf[3] * za[3]), cvt_pk_bf16(uf[4] * zb[0], uf[5] * zb[1]), cvt_pk_bf16(uf[6] * zb[2], uf[7] * zb[3])};
        }
    }
    __syncthreads();
}

__device__ __forceinline__ void mixer_phase(const Frame& F, const Args& a, const WsPtrs& w) {
    constexpr int NATT = BATCH * NCH * NQH, NSGU = BATCH * NCH * NG;
    for (int u = F.vcu; u < NATT + NSGU; u += F.G) {
        if (u < NATT) attn_unit(F, w.P, w.MIX, a.in[14], a.in[15], a.in[16], u >> 7, (u >> 3) & 15, u & 7);
        else { const int v = u - NATT; sgu_unit(F, w.P, w.MIX, w.WSP, a.in[10], a.in[11], a.in[13], v >> 6, (v >> 2) & 15, v & 3); }
    }
}

__global__ void __launch_bounds__(NWAVES * 64, 2) mega_fwd(Args args) {
    extern __shared__ __attribute__((aligned(16))) unsigned char lds[];
    Frame F;
    F.lds = (LAS unsigned char*)lds;
    F.MISC = (volatile LAS unsigned*)(F.lds + MISC_OFF);
    F.tid = threadIdx.x; F.lane = F.tid & 63; F.wave = __builtin_amdgcn_readfirstlane(F.tid >> 6);
    F.G = gridDim.x; { const int bx = blockIdx.x; F.vcu = (F.G % 8 == 0) ? (bx % 8) * (F.G / 8) + bx / 8 : bx; }
    unsigned char* ws = args.ws;
    WsPtrs w;
    w.mods = (float*)(ws + WS_MODS); w.cb1 = (float*)(ws + WS_CB1); w.cb2 = (float*)(ws + WS_CB2); w.cb3 = (float*)(ws + WS_CB3);
    w.ss1 = (float*)(ws + WS_SS1); w.ss2 = (float*)(ws + WS_CTL + CTL_SS2); w.ss3 = (float*)(ws + WS_CTL + CTL_SS3);
    w.WGU1 = (bf16_t*)(ws + WS_WGU1); w.WD1 = (bf16_t*)(ws + WS_WD1); w.WIN = (bf16_t*)(ws + WS_WIN); w.WA = (bf16_t*)(ws + WS_WA); w.WB = (bf16_t*)(ws + WS_WB);
    w.WO = (bf16_t*)(ws + WS_WO); w.WGU2 = (bf16_t*)(ws + WS_WGU2); w.WD2 = (bf16_t*)(ws + WS_WD2); w.WSP = (bf16_t*)(ws + WS_WSP);
    w.XN = (bf16_t*)(ws + WS_XN); w.MIX = (bf16_t*)(ws + WS_MIX); w.MERGED = (bf16_t*)(ws + WS_MERGED); w.ACT = (bf16_t*)(ws + WS_ACT); w.P = (bf16_t*)(ws + WS_P);
    for (int u = F.tid; u < (LDS_BYTES - LDSCTL_OFF) / 4; u += NWAVES * 64) ((LAS unsigned*)(F.lds + LDSCTL_OFF))[u] = 0u;
    __syncthreads();
    XcdBarrier bar = xcd_barrier_post((unsigned*)(ws + WS_CTL) + CW_BAR + args.li * XCD_BAR_WORDS, F.MISC + 8);
    const int lo = args.ph_lo, hi = args.ph_hi;
#define IN(k) (lo <= (k) && (k) < hi)
#define SEAM(k) do { if (IN(k) && IN((k) + 1)) xcd_barrier(bar); } while (0)
    const int cid = (int)blockIdx.x;
    float* out = args.out;

    if (IN(0)) { p0_prologue(F, args, w); SEAM(0); }
    if (IN(1)) { p1_phase(F, args, w); SEAM(1); }
    if (IN(2)) {
        pg8::Gemm g{w.XN, w.XN, w.WGU1, w.WGU1, D, D, D}; pg8::StaticOrder S; S.init(M, NGU, F.G, cid);
        EpiGU E{w.ACT, w.ss1, w.cb1};
        pg8::gemm_phase(F.lds + RING_OFF, g, S, E); SEAM(2);
    }
    if (IN(3)) {
        pg8::Gemm g{w.ACT, w.ACT, w.WD1, w.WD1, FF, FF, FF}; pg8::StaticOrder S; S.init(M, D, F.G, cid);
        EpiRes<true> E{args.in[0], out, w.mods + 2 * D, args.in[8], w.mods + 4 * D, w.XN, w.ss2, 0.5f};
        pg8::gemm_phase(F.lds + RING_OFF, g, S, E); SEAM(3);
    }
    if (IN(4)) {
        pg8::Gemm g{w.XN, w.XN, w.WIN, w.WIN, D, D, D}; pg8::StaticOrder S; S.init(M, NIN, F.G, cid);
        EpiWin E{w.P, w.ss2, w.cb2};
        pg8::gemm_phase(F.lds + RING_OFF, g, S, E); SEAM(4);
    }
    if (IN(5)) {
        mixer_phase(F, args, w); SEAM(5);
    }
    if (IN(6)) {
        pg8::Gemm g{w.MIX, w.MIX + 512, w.WA, w.WB, D, DA, DA}; pg8::StaticOrder S; S.init(M, D, F.G, cid, 2);
        EpiBranch E{w.P, w.MERGED};
        pg8::gemm_phase(F.lds + RING_OFF, g, S, E); SEAM(6);
    }
    if (IN(7)) {
        pg8::Gemm g{w.MERGED, w.MERGED, w.WO, w.WO, D, D, D}; pg8::StaticOrder S; S.init(M, D, F.G, cid);
        EpiRes<true> E{out, out, w.mods + 5 * D, args.in[20], w.mods + 7 * D, w.XN, w.ss3, 1.0f};
        pg8::gemm_phase(F.lds + RING_OFF, g, S, E); SEAM(7);
    }
    if (IN(8)) {
        pg8::Gemm g{w.XN, w.XN, w.WGU2, w.WGU2, D, D, D}; pg8::StaticOrder S; S.init(M, NGU, F.G, cid);
        EpiGU E{w.ACT, w.ss3, w.cb3};
        pg8::gemm_phase(F.lds + RING_OFF, g, S, E); SEAM(8);
    }
    if (IN(9)) {
        pg8::Gemm g{w.ACT, w.ACT, w.WD2, w.WD2, FF, FF, FF}; pg8::StaticOrder S; S.init(M, D, F.G, cid);
        EpiRes<false> E{out, out, w.mods + 8 * D, nullptr, nullptr, nullptr, nullptr, 0.5f};
        pg8::gemm_phase(F.lds + RING_OFF, g, S, E);
    }
#undef IN
#undef SEAM
}

extern "C" void kernel_launch(void* const* d_in, const int* in_sizes, int n_in, void* d_out, int out_size, void* d_ws, size_t ws_size, hipStream_t stream) {
    static int grid = 0;
    if (grid == 0) {
        if (n_in != 24 || in_sizes[0] != M * D || out_size != M * D || ws_size < WS_END) {
            fprintf(stderr, "kernel_launch: unexpected shapes (n_in %d, in0 %d, out %d, ws %zu < %zu); nothing launched\n", n_in, n_in > 0 ? in_sizes[0] : -1, out_size, ws_size, (size_t)WS_END); grid = -1; return; }
        int dev = 0, cus = 0, per_cu = 0;
        if (hipGetDevice(&dev) != hipSuccess || hipDeviceGetAttribute(&cus, hipDeviceAttributeMultiprocessorCount, dev) != hipSuccess) { fprintf(stderr, "kernel_launch: device query failed\n"); grid = -1; return; }
        if (hipFuncSetAttribute((const void*)mega_fwd, hipFuncAttributeMaxDynamicSharedMemorySize, LDS_BYTES) != hipSuccess) { fprintf(stderr, "kernel_launch: hipFuncSetAttribute failed\n"); grid = -1; return; }
        if (hipOccupancyMaxActiveBlocksPerMultiprocessor(&per_cu, (const void*)mega_fwd, NWAVES * 64, LDS_BYTES) != hipSuccess || per_cu < 1) {
            fprintf(stderr, "kernel_launch: occupancy query reports %d workgroups per CU; nothing launched\n", per_cu); (void)hipGetLastError(); grid = -1; return; }
        grid = cus;
        fprintf(stderr, "kernel_launch: grid %d (occupancy query: %d per CU)\n", grid, per_cu);
    }
    if (grid < 0) return;
    (void)hipMemsetAsync((char*)d_ws + WS_CTL, 0, CTL_BYTES, stream);
    Args a; memset(&a, 0, sizeof a);
    for (int i = 0; i < 24; ++i) a.in[i] = (const float*)d_in[i];
    a.out = (float*)d_out; a.ws = (unsigned char*)d_ws;
#if N_LAUNCHES == 1
    a.ph_lo = 0; a.ph_hi = 10; a.li = 0;
    hipLaunchKernelGGL(mega_fwd, dim3(grid), dim3(NWAVES * 64), LDS_BYTES, stream, a);
#else
    a.ph_lo = 0; a.ph_hi = 5; a.li = 0;
    hipLaunchKernelGGL(mega_fwd, dim3(grid), dim3(NWAVES * 64), LDS_BYTES, stream, a);
    {
        unsigned char* ws = (unsigned char*)d_ws; const float* const* in = (const float* const*)d_in;
        bf16_t* P = (bf16_t*)(ws + WS_P); bf16_t* MIX = (bf16_t*)(ws + WS_MIX); bf16_t* VN = (bf16_t*)(ws + WS_MERGED); bf16_t* WSP = (bf16_t*)(ws + WS_WSP);
        k_vln<<<M / 4, 256, 0, stream>>>(P, in[10], in[11], VN);
        k_sgu<<<M * 2, 256, 0, stream>>>(P, VN, WSP, in[13], MIX);
        k_attn<<<BATCH * NCH * NQH, 128, 0, stream>>>(P, in[14], in[15], in[16], MIX);
    }
    a.ph_lo = 6; a.ph_hi = 10; a.li = 1;
    hipLaunchKernelGGL(mega_fwd, dim3(grid), dim3(NWAVES * 64), LDS_BYTES, stream, a);
#endif
}
```

```cpp
#include <hip/hip_runtime.h>
#include <cstdio>
#include <cstdint>
#include <cstring>
#ifndef N_LAUNCHES
#define N_LAUNCHES 1
#endif

typedef unsigned short bf16_t;
typedef short bf16x8 __attribute__((ext_vector_type(8)));
typedef float f32x4 __attribute__((ext_vector_type(4)));
typedef float f32x2 __attribute__((ext_vector_type(2)));
typedef unsigned u32x4 __attribute__((ext_vector_type(4)));
typedef unsigned u32x2 __attribute__((ext_vector_type(2)));
#define GAS __attribute__((address_space(1)))
#define LAS __attribute__((address_space(3)))
#define RLX_AGENT __ATOMIC_RELAXED, __HIP_MEMORY_SCOPE_AGENT
#define LDS_WAIT() asm volatile("s_waitcnt lgkmcnt(0)" ::: "memory")
#define VM_WAIT() asm volatile("s_waitcnt vmcnt(0)" ::: "memory")

__device__ __forceinline__ float bf2f(bf16_t h) { return __uint_as_float(((unsigned)h) << 16); }
__device__ __forceinline__ unsigned f2bf(float f) { unsigned u = __float_as_uint(f); return (u + 0x7fffu + ((u >> 16) & 1u)) >> 16; }
__device__ __forceinline__ unsigned pk2(float lo, float hi) { return f2bf(lo) | (f2bf(hi) << 16); }
__device__ __forceinline__ unsigned cvt_pk_bf16(float lo, float hi) { unsigned r; asm volatile("v_cvt_pk_bf16_f32 %0, %1, %2" : "=v"(r) : "v"(lo), "v"(hi)); return r; }
__device__ __forceinline__ float bflo(unsigned w) { return __uint_as_float(w << 16); }
__device__ __forceinline__ float bfhi(unsigned w) { return __uint_as_float(w & 0xffff0000u); }

constexpr int BATCH = 16, SEQ = 2048, D = 1024, M = BATCH * SEQ;
constexpr int FF = 2816, NGU = 2 * FF;
constexpr int DA = 512, DB = 512, NIN = 3840, NMOD = 9 * D;
constexpr int CHUNK = 128, NCH = SEQ / CHUNK, NG = 4, GD = 128;
constexpr int HD = 64, NQH = 8, NKVH = 2;
constexpr int PC_U = 0, PC_V = 512, PC_Q = 1024, PC_K = 1536, PC_VV = 1664, PC_GA = 1792, PC_GB = 2816;
constexpr float EPS = 1e-6f;
constexpr float LOG2E = 1.4426950408889634f;

constexpr size_t MiB = 1u << 20;
constexpr size_t WS_CTL = 0, CTL_BYTES = 64 * 1024;
constexpr int CW_BAR = 4096;
constexpr size_t WS_MODS = 1 * MiB;
constexpr size_t WS_CB1 = WS_MODS + 640 * 1024;
constexpr size_t WS_CB2 = WS_CB1 + 352 * 1024;
constexpr size_t WS_CB3 = WS_CB2 + 240 * 1024;
constexpr size_t WS_SS1 = WS_CB3 + 352 * 1024;
constexpr size_t WS_SS2 = WS_SS1 + 512 * 1024, WS_SS3 = WS_SS2 + 512 * 1024;
constexpr size_t WS_SMALL_END = WS_SS3 + 512 * 1024;
static_assert(WS_SMALL_END <= 5 * MiB, "small tables");
constexpr size_t WS_WGU1 = 5 * MiB;
constexpr size_t WS_WD1 = WS_WGU1 + (size_t)NGU * D * 2;
constexpr size_t WS_WIN = WS_WD1 + (size_t)D * FF * 2;
constexpr size_t WS_WA = WS_WIN + (size_t)NIN * D * 2;
constexpr size_t WS_WB = WS_WA + (size_t)D * DA * 2;
constexpr size_t WS_WO = WS_WB + (size_t)D * DB * 2;
constexpr size_t WS_WGU2 = WS_WO + (size_t)D * D * 2;
constexpr size_t WS_WD2 = WS_WGU2 + (size_t)NGU * D * 2;
constexpr size_t WS_WSP = WS_WD2 + (size_t)D * FF * 2;
constexpr size_t WS_W_END = WS_WSP + (size_t)NG * CHUNK * CHUNK * 2;
static_assert(WS_W_END <= 50 * MiB, "weights");
constexpr size_t WS_XN = 50 * MiB;
constexpr size_t WS_MIX = 114 * MiB;
constexpr size_t WS_MERGED = 178 * MiB;
constexpr size_t WS_ACT = 242 * MiB;
constexpr size_t WS_P = 242 * MiB;
constexpr size_t WS_END = 482 * MiB;

#ifdef PROBE_STAMPS
#define STAMP(id) do { if (blockIdx.x == 0 && threadIdx.x == 0) ((unsigned long long*)(g_ws_ + WS_CTL))[40 + (id)] = __builtin_amdgcn_s_memrealtime(); } while (0)
#else
#define STAMP(id) do {} while (0)
#endif
__device__ __forceinline__ float fsigmoid(float v) { return __builtin_amdgcn_rcpf(1.0f + __builtin_amdgcn_exp2f(-LOG2E * v)); }
__device__ __forceinline__ float fgelu_tanh(float v) {
    const float u = 0.7978845608028654f * (v + 0.044715f * v * v * v);
    return v * fsigmoid(2.0f * u);
}

namespace pg8 {
constexpr int BM = 256, BK = 64, HALF = 128, HTB = HALF * BK * 2  , STAGE_BYTES = 8 * HTB, NXCD = 8, WGM = 8;

__host__ __device__ __forceinline__ int lds_byte(int r, int c) { const int st = (r >> 4) * 2 + (c >> 5), rr = r & 15, cc = c & 31, ob = rr * 64 + cc * 2; return st * 1024 + (ob ^ (((ob >> 9) & 1) << 5)); }
__host__ __device__ __forceinline__ void stage_rc(int b, int& R, int& C) { const int st = b / 1024, sb = b % 1024, swz = sb ^ (((sb >> 9) & 1) << 5); R = (st >> 1) * 16 + swz / 64; C = (st & 1) * 32 + (swz % 64) / 2; }
__host__ __device__ __forceinline__ int perm32(int rho) { const int n = rho >> 4, i = rho & 15; return 8 * (i >> 2) + 4 * n + (i & 3); }

struct Unit { int pm, pn, seg; };
struct Gemm { const bf16_t* A0; const bf16_t* A1; const bf16_t* B0; const bf16_t* B1; int lda, ldb, K; };

struct StaticOrder {
    int nM, nN, nwg, G, c, nseg;
    __host__ __device__ void init(int M_, int N_, int G_, int c_, int nseg_ = 1) { nM = M_ / BM; nN = N_ / BM; nwg = nM * nN; G = G_; c = c_; nseg = nseg_; }
    __host__ __device__ bool next(int i, Unit& u) const {
        const int ti = (nseg == 1) ? i : (i >> 1);
        const long L = (long)ti * G + c; if (L >= nwg) return false;
        int wgid = (int)L; { const int q = nwg / NXCD, r = nwg % NXCD, xcd = wgid % NXCD, off = wgid / NXCD; wgid = (xcd < r ? xcd * (q + 1) : r * (q + 1) + (xcd - r) * q) + off; }
        const int nig = WGM * nN, gid = wgid / nig, fm = gid * WGM, gsz = (nM - fm) < WGM ? (nM - fm) : WGM;
        u.pm = fm + ((wgid % nig) % gsz); u.pn = (wgid % nig) / gsz; u.seg = (nseg == 1) ? 0 : (i & 1); return true;
    }
};

template <class Epi, class Sched>
__device__ __forceinline__ void gemm_phase(LAS unsigned char* lds, const Gemm g, const Sched& S, const Epi& E, unsigned long long& epi_ticks) {
    const int tid = threadIdx.x, wid = __builtin_amdgcn_readfirstlane(tid >> 6), lane = tid & 63, wr = wid >> 2, wc = wid & 3, fr = lane & 15, fq = lane >> 4;
    const int nt = g.K / BK;
    unsigned voffA[2], voffB[2];
#pragma unroll
    for (int i = 0; i < 2; ++i) { int R, C; stage_rc(tid * 16 + i * 8192, R, C); const int Rb = Epi::MAPB ? ((R >> 5) * 64 + perm32(R & 31)) : ((R & ~31) + perm32(R & 31));
        voffA[i] = (unsigned)(R * g.lda + C) * 2u; voffB[i] = (unsigned)(Rb * g.ldb + C) * 2u; }
    const size_t kstep = (size_t)(BK * 2);
    const size_t hstepA = (size_t)HALF * g.lda * 2, hstepB = (size_t)HALF * g.ldb * 2;
    const size_t tstepA = 2 * hstepA, tstepB = 2 * hstepB;
    const size_t hoffB = Epi::MAPB ? (size_t)32 * g.ldb * 2 : hstepB;
    const unsigned ldsw = (unsigned)wid * 1024u;
    const int aoff = lds_byte(wr * 64 + fr, fq * 8), boff = lds_byte(wc * 32 + fr, fq * 8);
#define PG8_SA(b, h) (((b) * 2 + (h)) * HTB)
#define PG8_SB(b, h) ((4 + (b) * 2 + (h)) * HTB)
#define PG8_STAGE(bufoff, gbase, voff) do { _Pragma("unroll") for (int _i = 0; _i < 2; ++_i) \
        __builtin_amdgcn_global_load_lds((const unsigned*)((const char*)(gbase) + (voff)[_i]), (LAS unsigned*)(lds + (bufoff) + ldsw + _i * 8192), 16, 0, 0); } while (0)
#define PG8_LDA(dst, b, h) do { _Pragma("unroll") for (int m = 0; m < 4; ++m) _Pragma("unroll") for (int k = 0; k < 2; ++k) dst[m][k] = *(const LAS bf16x8*)(lds + PG8_SA(b, h) + aoff + m * 2048 + k * 1024); } while (0)
#define PG8_LDB(dst, b, h) do { _Pragma("unroll") for (int n = 0; n < 2; ++n) _Pragma("unroll") for (int k = 0; k < 2; ++k) dst[n][k] = *(const LAS bf16x8*)(lds + PG8_SB(b, h) + boff + n * 2048 + k * 1024); } while (0)
#define PG8_MMA(ai, bj, At, Bt) do { __builtin_amdgcn_s_setprio(1); _Pragma("unroll") for (int m = 0; m < 4; ++m) _Pragma("unroll") for (int n = 0; n < 2; ++n) _Pragma("unroll") for (int k = 0; k < 2; ++k) \
        acc[ai][bj][m][n] = __builtin_amdgcn_mfma_f32_16x16x32_bf16(Bt[n][k], At[m][k], acc[ai][bj][m][n], 0, 0, 0); __builtin_amdgcn_s_setprio(0); } while (0)
#define PG8_WAIT_V(n) asm volatile("s_waitcnt vmcnt(" #n ")" ::: "memory")
#define PG8_WAIT_L(n) asm volatile("s_waitcnt lgkmcnt(" #n ")" ::: "memory")
#define PG8_BAR __builtin_amdgcn_s_barrier()
#define PG8_SCHED __builtin_amdgcn_sched_barrier(0)
    Unit cur, nxt; int ui = 0;
    if (!S.next(0, cur)) return;
    f32x4 acc[2][2][4][2];
#pragma unroll
    for (int a = 0; a < 2; ++a)
#pragma unroll
        for (int b = 0; b < 2; ++b)
#pragma unroll
            for (int m = 0; m < 4; ++m)
#pragma unroll
                for (int n = 0; n < 2; ++n) acc[a][b][m][n] = (f32x4){0.f, 0.f, 0.f, 0.f};
    bf16x8 At[4][2], B0[2][2], B1[2][2];
    const char* cA = (const char*)(cur.seg ? g.A1 : g.A0) + (size_t)cur.pm * tstepA; const char* cB = (const char*)(cur.seg ? g.B1 : g.B0) + (size_t)cur.pn * tstepB;
    PG8_STAGE(PG8_SB(0, 0), cB, voffB); PG8_STAGE(PG8_SB(0, 1), cB + hoffB, voffB); PG8_STAGE(PG8_SA(0, 0), cA, voffA); PG8_STAGE(PG8_SA(0, 1), cA + hstepA, voffA);
    if (wr == 1) PG8_BAR;
    PG8_WAIT_V(2); PG8_BAR;
    PG8_STAGE(PG8_SB(1, 0), cB + kstep, voffB); PG8_STAGE(PG8_SA(1, 0), cA + kstep, voffA); PG8_STAGE(PG8_SB(1, 1), cB + hoffB + kstep, voffB);
    PG8_WAIT_V(6); PG8_BAR;
    for (;;) {
        const bool has_next = S.next(ui + 1, nxt);
        const char* nA = has_next ? (const char*)(nxt.seg ? g.A1 : g.A0) + (size_t)nxt.pm * tstepA : cA; const char* nB = has_next ? (const char*)(nxt.seg ? g.B1 : g.B0) + (size_t)nxt.pn * tstepB : cB;
#ifdef PROBE_KLOOP
        const unsigned long long tk0_ = __builtin_amdgcn_s_memrealtime();
#endif
        for (int t = 0; t < nt; t += 2) {
            const bool last = (t == nt - 2);
            const char* a1 = cA + (size_t)(t + 1) * kstep;
            const char* a2 = last ? nA : cA + (size_t)(t + 2) * kstep; const char* b2 = last ? nB : cB + (size_t)(t + 2) * kstep;
            const char* a3 = a2 + kstep; const char* b3 = b2 + kstep;
            PG8_LDB(B0, 0, 0); PG8_LDB(B1, 0, 1); PG8_SCHED; PG8_LDA(At, 0, 0); PG8_STAGE(PG8_SA(1, 1), a1 + hstepA, voffA);
            PG8_WAIT_V(8); PG8_WAIT_L(0); PG8_BAR; PG8_MMA(0, 0, At, B0); PG8_MMA(0, 1, At, B1); PG8_BAR; PG8_SCHED;
            PG8_LDA(At, 0, 1); PG8_STAGE(PG8_SB(0, 0), b2, voffB); PG8_STAGE(PG8_SB(0, 1), b2 + hoffB, voffB); PG8_STAGE(PG8_SA(0, 0), a2, voffA);
            PG8_WAIT_V(8); PG8_WAIT_L(0); PG8_BAR; PG8_MMA(1, 0, At, B0); PG8_MMA(1, 1, At, B1); PG8_BAR; PG8_SCHED;
            PG8_LDB(B0, 1, 0); PG8_LDB(B1, 1, 1); PG8_SCHED; PG8_LDA(At, 1, 0); PG8_STAGE(PG8_SA(0, 1), a2 + hstepA, voffA);
            PG8_WAIT_V(8); PG8_WAIT_L(0); PG8_BAR; PG8_MMA(0, 0, At, B0); PG8_MMA(0, 1, At, B1); PG8_BAR; PG8_SCHED;
            PG8_LDA(At, 1, 1); PG8_STAGE(PG8_SB(1, 0), b3, voffB); PG8_STAGE(PG8_SB(1, 1), b3 + hoffB, voffB); PG8_STAGE(PG8_SA(1, 0), a3, voffA);
            PG8_WAIT_V(8); PG8_WAIT_L(0); PG8_BAR; PG8_MMA(1, 0, At, B0); PG8_MMA(1, 1, At, B1); PG8_BAR; PG8_SCHED;
        }
#ifdef PROBE_KLOOP
        epi_ticks += __builtin_amdgcn_s_memrealtime() - tk0_;
#endif
        if (wr == 0) PG8_BAR;
#ifdef PROBE_LO
        const unsigned long long te0_ = __builtin_amdgcn_s_memrealtime();
#endif
        const bool keep = E(acc, cur, wr, wc, fr, fq);
#if defined(PROBE_LO) && !defined(PROBE_KLOOP)
        asm volatile("s_waitcnt vmcnt(0)" ::: "memory"); epi_ticks += __builtin_amdgcn_s_memrealtime() - te0_;
#endif
        if (!has_next) break;
        if (!keep) {
#pragma unroll
            for (int a = 0; a < 2; ++a)
#pragma unroll
                for (int b = 0; b < 2; ++b)
#pragma unroll
                    for (int m = 0; m < 4; ++m)
#pragma unroll
                        for (int n = 0; n < 2; ++n) acc[a][b][m][n] = (f32x4){0.f, 0.f, 0.f, 0.f};
        }
        cur = nxt; cA = nA; cB = nB; ++ui;
        if (wr == 1) PG8_BAR;
    }
    PG8_WAIT_V(0);
    PG8_BAR;
#undef PG8_SA
#undef PG8_SB
#undef PG8_STAGE
#undef PG8_LDA
#undef PG8_LDB
#undef PG8_MMA
#undef PG8_WAIT_V
#undef PG8_WAIT_L
#undef PG8_BAR
#undef PG8_SCHED
}
}

using pg8::Unit;
template <bool MAPB> __device__ __forceinline__ int colbase(const Unit& u, int bj, int wc, int fq) { return MAPB ? (u.pn * 256 + wc * 64 + bj * 32 + 8 * fq) : (u.pn * 256 + bj * 128 + wc * 32 + 8 * fq); }
__device__ __forceinline__ float rstd_of(const float* ss, int m) { const f32x4 p = *(const f32x4*)(ss + 4 * (size_t)m); return __builtin_amdgcn_rsqf(((p[0] + p[1]) + (p[2] + p[3])) * (1.0f / D) + EPS); }

template <bool RAW  > struct EpiGU {
    static constexpr bool MAPB = false;
    bf16_t* act; const float* ss; const float* cb;
    __device__ __forceinline__ bool operator()(f32x4 (&acc)[2][2][4][2], const Unit& u, int wr, int wc, int fr, int fq) const {
        const int b = u.pm >> 3;
        const float* cbp = cb + b * NGU + u.pn * 256 + wc * 32 + 8 * fq;
        f32x4 cg[2], cu[2];
        if constexpr (!RAW) {
#pragma unroll
            for (int n = 0; n < 2; ++n) { cg[n] = *(const f32x4*)(cbp + 4 * n); cu[n] = *(const f32x4*)(cbp + 128 + 4 * n); } }
#pragma unroll
        for (int ai = 0; ai < 2; ++ai)
#pragma unroll
            for (int m = 0; m < 4; ++m) {
                const int row = u.pm * 256 + ai * 128 + wr * 64 + m * 16 + fr; float rs = 1.0f; if constexpr (!RAW) rs = rstd_of(ss, row);
                unsigned w[4];
#pragma unroll
                for (int n = 0; n < 2; ++n) { f32x4 gv = acc[ai][0][m][n], uv = acc[ai][1][m][n]; if constexpr (!RAW) { gv = gv * rs + cg[n]; uv = uv * rs + cu[n]; } float o[4];
#pragma unroll
                    for (int i = 0; i < 4; ++i) o[i] = gv[i] * uv[i] * fsigmoid(gv[i]);
                    w[2 * n] = cvt_pk_bf16(o[0], o[1]); w[2 * n + 1] = cvt_pk_bf16(o[2], o[3]); }
                __builtin_nontemporal_store((u32x4){w[0], w[1], w[2], w[3]}, (u32x4*)(act + (size_t)row * FF + u.pn * 128 + wc * 32 + 8 * fq));
            }
        return false;
    }
};
template <bool NORM> struct EpiRes {
    static constexpr bool MAPB = true;
    const float* resid; float* hout; const float* ga; const float* gn; const float* sc; bf16_t* xn; float* ssq; LAS float* red; float gscale;
    __device__ __forceinline__ bool operator()(f32x4 (&acc)[2][2][4][2], const Unit& u, int wr, int wc, int fr, int fq) const {
        const int b = u.pm >> 3; constexpr bool donorm = NORM;
        f32x4 gav[2][2], gsv[2][2];
#pragma unroll
        for (int bj = 0; bj < 2; ++bj)
#pragma unroll
            for (int n = 0; n < 2; ++n) { const int c = colbase<MAPB>(u, bj, wc, fq) + 4 * n;
                gav[bj][n] = *(const f32x4*)(ga + b * NMOD + c) * gscale;
                if constexpr (NORM) gsv[bj][n] = *(const f32x4*)(gn + c) * (*(const f32x4*)(sc + b * NMOD + c) + 1.0f); }
#pragma unroll
        for (int ai = 0; ai < 2; ++ai)
#pragma unroll
            for (int m = 0; m < 4; ++m) {
                const int row = u.pm * 256 + ai * 128 + wr * 64 + m * 16 + fr; float s = 0.f;
#pragma unroll
                for (int bj = 0; bj < 2; ++bj) { const size_t off = (size_t)row * D + colbase<MAPB>(u, bj, wc, fq);
                    const f32x4 r0 = *(const f32x4*)(resid + off), r1 = *(const f32x4*)(resid + off + 4);
                    const f32x4 v0 = r0 + gav[bj][0] * acc[ai][bj][m][0], v1 = r1 + gav[bj][1] * acc[ai][bj][m][1];
                    __builtin_nontemporal_store(v0, (f32x4*)(hout + off)); __builtin_nontemporal_store(v1, (f32x4*)(hout + off + 4));
                    if constexpr (NORM) { const f32x4 a0 = v0 * gsv[bj][0], a1 = v1 * gsv[bj][1];
#ifndef PROBE_NOXN
                        *(u32x4*)(xn + off) = (u32x4){cvt_pk_bf16(a0[0], a0[1]), cvt_pk_bf16(a0[2], a0[3]), cvt_pk_bf16(a1[0], a1[1]), cvt_pk_bf16(a1[2], a1[3])};
#else
                        asm volatile("" :: "v"(a0), "v"(a1));
#endif
                        s += (v0[0] * v0[0] + v0[1] * v0[1]) + (v0[2] * v0[2] + v0[3] * v0[3]) + (v1[0] * v1[0] + v1[1] * v1[1]) + (v1[2] * v1[2] + v1[3] * v1[3]); } }
                if constexpr (NORM) { s += __shfl_xor(s, 16); s += __shfl_xor(s, 32); if (fq == 0) red[(ai * 128 + wr * 64 + m * 16 + fr) * 4 + wc] = s; }
                if (m == 3) asm volatile("" ::: "memory");
            }
        if constexpr (NORM) {
            asm volatile("s_waitcnt lgkmcnt(0)" ::: "memory"); __builtin_amdgcn_s_barrier(); asm volatile("" ::: "memory");
            const int tid = threadIdx.x;
            if (tid < 256) { const f32x4 p = *(const LAS f32x4*)(red + 4 * tid); ssq[(size_t)(u.pm * 256 + tid) * 4 + u.pn] = (p[0] + p[1]) + (p[2] + p[3]); }
        }
        return false;
    }
};
struct EpiWin {
    static constexpr bool MAPB = true;
    bf16_t* P; const float* ss; const float* cb;
    __device__ __forceinline__ bool operator()(f32x4 (&acc)[2][2][4][2], const Unit& u, int wr, int wc, int fr, int fq) const {
        const int b = u.pm >> 3; const int kind = u.pn < 4 ? 0 : (u.pn < 7 ? 1 : 2);
        f32x4 cv[2][2];
#pragma unroll
        for (int bj = 0; bj < 2; ++bj)
#pragma unroll
            for (int n = 0; n < 2; ++n) cv[bj][n] = *(const f32x4*)(cb + b * NIN + colbase<MAPB>(u, bj, wc, fq) + 4 * n);
#pragma unroll
        for (int ai = 0; ai < 2; ++ai)
#pragma unroll
            for (int m = 0; m < 4; ++m) {
                const int row = u.pm * 256 + ai * 128 + wr * 64 + m * 16 + fr; const float rs = rstd_of(ss, row);
#pragma unroll
                for (int bj = 0; bj < 2; ++bj) { unsigned w[4];
#pragma unroll
                    for (int n = 0; n < 2; ++n) { f32x4 v = acc[ai][bj][m][n] * rs + cv[bj][n];
                        if (kind == 0) { v[0] = fgelu_tanh(v[0]); v[1] = fgelu_tanh(v[1]); v[2] = fgelu_tanh(v[2]); v[3] = fgelu_tanh(v[3]); }
                        else if (kind == 2) { v[0] = fsigmoid(v[0]); v[1] = fsigmoid(v[1]); v[2] = fsigmoid(v[2]); v[3] = fsigmoid(v[3]); }
                        w[2 * n] = cvt_pk_bf16(v[0], v[1]); w[2 * n + 1] = cvt_pk_bf16(v[2], v[3]); }
                    __builtin_nontemporal_store((u32x4){w[0], w[1], w[2], w[3]}, (u32x4*)(P + (size_t)row * NIN + colbase<MAPB>(u, bj, wc, fq))); }
            }
        return false;
    }
};
struct EpiBranch {
    static constexpr bool MAPB = true;
    const bf16_t* P; bf16_t* merged;
    __device__ __forceinline__ bool operator()(f32x4 (&acc)[2][2][4][2], const Unit& u, int wr, int wc, int fr, int fq) const {
#pragma unroll
        for (int ai = 0; ai < 2; ++ai)
#pragma unroll
            for (int m = 0; m < 4; ++m) {
                const int row = u.pm * 256 + ai * 128 + wr * 64 + m * 16 + fr;
#pragma unroll
                for (int bj = 0; bj < 2; ++bj) { const int c = colbase<MAPB>(u, bj, wc, fq);
                    const u32x4 gb = *(const u32x4*)(P + (size_t)row * NIN + PC_GB + c);
                    float sb[8] = {bflo(gb[0]), bfhi(gb[0]), bflo(gb[1]), bfhi(gb[1]), bflo(gb[2]), bfhi(gb[2]), bflo(gb[3]), bfhi(gb[3])};
                    if (u.seg == 0) {
                        const u32x4 gaw = *(const u32x4*)(P + (size_t)row * NIN + PC_GA + c);
                        const float sa[8] = {bflo(gaw[0]), bfhi(gaw[0]), bflo(gaw[1]), bfhi(gaw[1]), bflo(gaw[2]), bfhi(gaw[2]), bflo(gaw[3]), bfhi(gaw[3])};
#pragma unroll
                        for (int i = 0; i < 4; ++i) { acc[ai][bj][m][0][i] *= sa[i] * __builtin_amdgcn_rcpf(fmaxf(sb[i], 1e-30f)); acc[ai][bj][m][1][i] *= sa[4 + i] * __builtin_amdgcn_rcpf(fmaxf(sb[4 + i], 1e-30f)); }
                    } else {
                        const f32x4 a0 = acc[ai][bj][m][0], a1 = acc[ai][bj][m][1];
                        *(u32x4*)(merged + (size_t)row * D + c) = (u32x4){cvt_pk_bf16(a0[0] * sb[0], a0[1] * sb[1]), cvt_pk_bf16(a0[2] * sb[2], a0[3] * sb[3]), cvt_pk_bf16(a1[0] * sb[4], a1[1] * sb[5]), cvt_pk_bf16(a1[2] * sb[6], a1[3] * sb[7])};
                    } }
                if (m == 3) asm volatile("" ::: "memory");
            }
        return u.seg == 0;
    }
};

#define XB_TMO      128
#define XB_XCNT(j)  (256  + 64 * (j))
#define XB_XSUB(j)  (1280 + 64 * (j))
#define XB_XGEN(j)  (2304 + 64 * (j))
#define XB_TOP      3328
#define XB_TOPGEN   3392
#define XCD_BAR_WORDS 3456
#define XB_SPIN_CAP (1u << 18)

__device__ __forceinline__ unsigned xb_ld(unsigned* p)              { return __hip_atomic_load(p, __ATOMIC_RELAXED, __HIP_MEMORY_SCOPE_AGENT); }
__device__ __forceinline__ unsigned xb_add(unsigned* p, unsigned v) { return __hip_atomic_fetch_add(p, v, __ATOMIC_RELAXED, __HIP_MEMORY_SCOPE_AGENT); }
__device__ __forceinline__ unsigned xb_xcc_id() { return (unsigned)__builtin_amdgcn_s_getreg((3 << 11) | 20) & 0xFu; }
#define XB_SPIN(cond, bar) do { unsigned _sp = 0; while (cond) { __builtin_amdgcn_s_sleep(1); \
    if ((++_sp & 255u) == 0u) { if (xb_ld(&(bar)[XB_TMO])) break; if (_sp > XB_SPIN_CAP) { atomicAdd(&(bar)[XB_TMO], 1u); break; } } } } while (0)

struct XcdBarrier {
    unsigned* bar; unsigned x;
    volatile LAS unsigned* st;
};

__device__ __forceinline__ XcdBarrier xcd_barrier_post(unsigned* bar, volatile LAS unsigned* st) {
    XcdBarrier b; b.bar = bar; b.x = xb_xcc_id(); b.st = st;
    if (threadIdx.x == 0) (void)xb_add(&bar[XB_XCNT(b.x)], 1u);
    return b;
}
__device__ __forceinline__ void xcd_barrier_complete(unsigned* bar, unsigned x, unsigned& nloc, unsigned& nx) {
    const unsigned G = gridDim.x * gridDim.y * gridDim.z;
    unsigned sum, cnt, mine, sp = 0u;
    for (;;) {
        sum = 0u; cnt = 0u; mine = 0u;
#pragma unroll
        for (unsigned j = 0; j < 16; ++j) { const unsigned c = xb_ld(&bar[XB_XCNT(j)]); sum += c; cnt += (c > 0u) ? 1u : 0u; mine = (j == x) ? c : mine; }
        if (sum == G) break;
        __builtin_amdgcn_s_sleep(1);
        if ((++sp & 255u) == 0u) { if (xb_ld(&bar[XB_TMO])) break; if (sp > XB_SPIN_CAP) { atomicAdd(&bar[XB_TMO], 1u); break; } }
    }
    nloc = mine > 0u ? mine : 1u; nx = cnt > 0u ? cnt : 1u;
}

__device__ __forceinline__ void xcd_barrier(const XcdBarrier& b) {
    asm volatile("s_waitcnt vmcnt(0)" ::: "memory");
    __syncthreads();
    if (threadIdx.x == 0) {
        unsigned* bar = b.bar;
        __builtin_amdgcn_s_waitcnt(0);
        unsigned nloc = b.st[0], nx = b.st[1];
        if (nloc == 0u) { xcd_barrier_complete(bar, b.x, nloc, nx); b.st[0] = nloc; b.st[1] = nx; }
        const unsigned old = xb_add(&bar[XB_XSUB(b.x)], 1u);
        const unsigned gen = old / nloc;
        if (old + 1u == (gen + 1u) * nloc) {
            __builtin_amdgcn_fence(__ATOMIC_RELEASE, "agent");
            asm volatile("s_waitcnt vmcnt(0)" ::: "memory");
            const unsigned og = xb_add(&bar[XB_TOP], 1u);
            const unsigned tg = og / nx;
            if (og + 1u == (tg + 1u) * nx) xb_add(&bar[XB_TOPGEN], 1u);
            else XB_SPIN(xb_ld(&bar[XB_TOPGEN]) == tg, bar);
            __builtin_amdgcn_fence(__ATOMIC_ACQUIRE, "agent");
            xb_add(&bar[XB_XGEN(b.x)], 1u);
            asm volatile("s_waitcnt vmcnt(0)" ::: "memory");
        } else {
            XB_SPIN(xb_ld(&bar[XB_XGEN(b.x)]) == gen, bar);
            __builtin_amdgcn_fence(__ATOMIC_ACQUIRE, "agent");
            asm volatile("s_waitcnt vmcnt(0)" ::: "memory");
        }
    }
    __syncthreads();
}

constexpr int NWAVES = 8;
constexpr int RING_OFF = 0, RING_BYTES = 131072;
constexpr int LDSCTL_OFF = RING_BYTES, MISC_OFF = LDSCTL_OFF + 320, RED_OFF = LDSCTL_OFF + 4096;
constexpr int LDS_BYTES = 147456;
static_assert(MISC_OFF + 128 <= RED_OFF && RED_OFF + 4096 <= LDS_BYTES, "LDS map");

struct Frame {
    LAS unsigned char* lds;
    volatile LAS unsigned* MISC;
    int tid, lane, wave;
    int vcu, G;
};
struct Args { const float* in[24]; float* out; unsigned char* ws; int ph_lo, ph_hi, li, pad; };

__device__ __forceinline__ float wave_sum(float v) {
#pragma unroll
    for (int o = 1; o < 64; o <<= 1) v += __shfl_xor(v, o);
    return v;
}
__device__ __forceinline__ void p0_mods_item(const Frame& F, const float* c, const float* w_ada, const float* b_ada, float* mods, int item, bool fill) {
    LAS float* sc = (LAS float*)(F.lds + RING_OFF);
    LAS float* red = (LAS float*)(F.lds + RING_OFF + 65536);
    if (fill) { for (int i = F.tid; i < BATCH * D; i += NWAVES * 64) { const float v = c[i]; sc[i] = v * fsigmoid(v); } __syncthreads(); }
    const int j = item * 64 + F.lane, k0 = F.wave * 128;
    float acc[BATCH];
#pragma unroll
    for (int b = 0; b < BATCH; ++b) acc[b] = 0.f;
#pragma unroll 2
    for (int kb = 0; kb < 128; kb += 16) {
        float wv[16];
#pragma unroll
        for (int i = 0; i < 16; ++i) wv[i] = w_ada[(size_t)(k0 + kb + i) * NMOD + j];
#pragma unroll
        for (int q = 0; q < 4; ++q)
#pragma unroll
            for (int b = 0; b < BATCH; ++b) { const f32x4 s4 = *(const LAS f32x4*)(sc + b * D + k0 + kb + 4 * q);
                acc[b] += s4[0] * wv[4 * q] + s4[1] * wv[4 * q + 1] + s4[2] * wv[4 * q + 2] + s4[3] * wv[4 * q + 3]; }
    }
#pragma unroll
    for (int b = 0; b < BATCH; ++b) red[(F.wave * BATCH + b) * 64 + F.lane] = acc[b];
    __syncthreads();
    for (int i = F.tid; i < BATCH * 64; i += NWAVES * 64) { const int b = i >> 6, l = i & 63; float s = 0.f;
#pragma unroll
        for (int w = 0; w < NWAVES; ++w) s += red[(w * BATCH + b) * 64 + l];
        mods[b * NMOD + item * 64 + l] = s + b_ada[item * 64 + l]; }
    __syncthreads();
}
__device__ __forceinline__ void p0_transpose_item(const float* W, int K, int N, bf16_t* WT, int gu, LAS float* scr, int item, int lane) {
    const int nblk = N / 32, kb = item / nblk, nb = item % nblk, k0 = 64 * kb, n0 = 32 * nb;
    {
        const int kk = lane >> 3, nq = lane & 7; f32x4 v[8];
#pragma unroll
        for (int i = 0; i < 8; ++i) v[i] = *(const f32x4*)(W + (size_t)(k0 + 8 * i + kk) * N + n0 + 4 * nq);
#pragma unroll
        for (int i = 0; i < 8; ++i) { LAS float* d = scr + (8 * i + kk) * 33 + 4 * nq; d[0] = v[i][0]; d[1] = v[i][1]; d[2] = v[i][2]; d[3] = v[i][3]; }
    }
    LDS_WAIT(); asm volatile("" ::: "memory");
    const int c = lane & 7;
    const int r0 = gu ? (256 * (n0 >> 7) + (n0 & 127) + 128 * (gu - 1)) : n0;
#pragma unroll
    for (int j = 0; j < 4; ++j) { const int n = (lane >> 3) + 8 * j; const LAS float* s = scr + (8 * c) * 33 + n;
        u32x4 o; o.x = pk2(s[0 * 33], s[1 * 33]); o.y = pk2(s[2 * 33], s[3 * 33]); o.z = pk2(s[4 * 33], s[5 * 33]); o.w = pk2(s[6 * 33], s[7 * 33]);
        *(GAS u32x4*)(WT + (size_t)(r0 + n) * K + k0 + 8 * c) = o; }
    LDS_WAIT(); asm volatile("" ::: "memory");
}
struct WsPtrs {
    float *mods, *cb1, *cb2, *cb3, *ss1, *ss2, *ss3;
    bf16_t *WGU1, *WD1, *WIN, *WA, *WB, *WO, *WGU2, *WD2, *WSP, *XN, *MIX, *MERGED, *ACT, *P;
};
__device__ __forceinline__ void late_conversions(const Frame& F, const Args& a, const WsPtrs& w, int widx, int NW) {
    LAS float* scr = (LAS float*)(F.lds + RING_OFF + F.wave * 16384);
    constexpr int I_G = (D / 64) * (FF / 32), I_D = (FF / 64) * (D / 32);
    for (int it = widx; it < 2 * I_G + I_D; it += NW) {
        int r = it;
        if (r < I_G) { p0_transpose_item(a.in[21], D, FF, w.WGU2, 1, scr, r, F.lane); continue; } r -= I_G;
        if (r < I_G) { p0_transpose_item(a.in[22], D, FF, w.WGU2, 2, scr, r, F.lane); continue; } r -= I_G;
        p0_transpose_item(a.in[23], FF, D, w.WD2, 0, scr, r, F.lane);
    }
}
__device__ __forceinline__ void xpass(const Frame& F, const Args& a, const WsPtrs& w);
constexpr int CW_MODS_DONE = 128;
__device__ __forceinline__ void p0_prologue(const Frame& F, const Args& a, const WsPtrs& w) {
    if (F.vcu < NMOD / 64) p0_mods_item(F, a.in[1], a.in[2], a.in[3], w.mods, F.vcu, true);
    LAS float* scr = (LAS float*)(F.lds + RING_OFF + F.wave * 16384);
    const int gw = F.vcu * NWAVES + F.wave, NGW = F.G * NWAVES;
    constexpr int I_G = (D / 64) * (FF / 32), I_D = (FF / 64) * (D / 32), I_IN = (D / 64) * (NIN / 32), I_AB = (DA / 64) * (D / 32), I_O = (D / 64) * (D / 32);
    constexpr int NITEMS = 4 * I_G + 2 * I_D + I_IN + 2 * I_AB + I_O;
    constexpr int NMODCU = NMOD / 64, R0 = 4;
    const bool balanced = (F.G == 256);
    const int nfree = (F.G - NMODCU) * NWAVES, early = balanced ? R0 * nfree : 0;
    for (int rho = 0;; ++rho) {
        int it;
        if (!balanced) it = rho * NGW + gw;
        else if (rho < R0) { if (F.vcu < NMODCU) continue; it = rho * nfree + (F.vcu - NMODCU) * NWAVES + F.wave; }
        else it = early + (rho - R0) * NGW + gw;
        if (it >= NITEMS) break;
        int r = it;
        if (r < I_G) { p0_transpose_item(a.in[5], D, FF, w.WGU1, 1, scr, r, F.lane); continue; } r -= I_G;
        if (r < I_G) { p0_transpose_item(a.in[6], D, FF, w.WGU1, 2, scr, r, F.lane); continue; } r -= I_G;
        if (r < I_D) { p0_transpose_item(a.in[7], FF, D, w.WD1, 0, scr, r, F.lane); continue; } r -= I_D;
        if (r < I_IN) { p0_transpose_item(a.in[9], D, NIN, w.WIN, 0, scr, r, F.lane); continue; } r -= I_IN;
        if (r < I_AB) { p0_transpose_item(a.in[17], DA, D, w.WA, 0, scr, r, F.lane); continue; } r -= I_AB;
        if (r < I_AB) { p0_transpose_item(a.in[18], DB, D, w.WB, 0, scr, r, F.lane); continue; } r -= I_AB;
        if (r < I_O) { p0_transpose_item(a.in[19], D, D, w.WO, 0, scr, r, F.lane); continue; } r -= I_O;
        if (r < I_G) { p0_transpose_item(a.in[21], D, FF, w.WGU2, 1, scr, r, F.lane); continue; } r -= I_G;
        if (r < I_G) { p0_transpose_item(a.in[22], D, FF, w.WGU2, 2, scr, r, F.lane); continue; } r -= I_G;
        p0_transpose_item(a.in[23], FF, D, w.WD2, 0, scr, r, F.lane);
    }
    for (int i = (F.vcu * NWAVES * 64 + F.tid); i < NG * CHUNK * CHUNK; i += F.G * NWAVES * 64) { const int s = i & 127, t = (i >> 7) & 127; w.WSP[i] = (bf16_t)f2bf(s <= t ? a.in[12][i] : 0.f); }
}
__device__ __forceinline__ void p1_cb_item(const Frame& F, const float* sh  , const bf16_t* Wt, int N, float* cb, int item) {
    const int r = F.lane & 15, g = F.lane >> 4, R0 = item * 16;
    const bf16_t* wp = Wt + (size_t)(R0 + r) * D + 8 * g; const float* sp = sh + r * NMOD + 8 * g;
    f32x4 acc = (f32x4){0.f, 0.f, 0.f, 0.f};
#pragma unroll 16
    for (int ks = 0; ks < D / 32; ++ks) {
        const bf16x8 wa = *(const bf16x8*)(wp + 32 * ks);
        const f32x4 s0 = *(const f32x4*)(sp + 32 * ks), s1 = *(const f32x4*)(sp + 32 * ks + 4);
        const float sv[8] = {s0[0], s0[1], s0[2], s0[3], s1[0], s1[1], s1[2], s1[3]};
        unsigned hi[4], lo[4];
#pragma unroll
        for (int i = 0; i < 4; ++i) { const unsigned h0 = f2bf(sv[2 * i]), h1 = f2bf(sv[2 * i + 1]); hi[i] = h0 | (h1 << 16);
            lo[i] = f2bf(sv[2 * i] - __uint_as_float(h0 << 16)) | (f2bf(sv[2 * i + 1] - __uint_as_float(h1 << 16)) << 16); }
        acc = __builtin_amdgcn_mfma_f32_16x16x32_bf16(wa, __builtin_bit_cast(bf16x8, (u32x4){hi[0], hi[1], hi[2], hi[3]}), acc, 0, 0, 0);
        acc = __builtin_amdgcn_mfma_f32_16x16x32_bf16(wa, __builtin_bit_cast(bf16x8, (u32x4){lo[0], lo[1], lo[2], lo[3]}), acc, 0, 0, 0);
    }
    *(f32x4*)(cb + (size_t)r * N + R0 + 4 * g) = acc;
}
__device__ __forceinline__ void xpass(const Frame& F, const Args& a, const WsPtrs& w) {
    const int gw = F.vcu * NWAVES + F.wave, NGW = F.G * NWAVES;
    for (int blk = gw; blk < M / 16; blk += NGW) {
        const int m0 = blk * 16, b = m0 >> 11;
        f32x4 gsv[2][2], shv[2][2];
#pragma unroll
        for (int j = 0; j < 2; ++j)
#pragma unroll
            for (int h = 0; h < 2; ++h) { const int k = j * 512 + F.lane * 8 + h * 4; gsv[j][h] = *(const f32x4*)(a.in[4] + k) * (*(const f32x4*)(w.mods + b * NMOD + 1 * D + k) + 1.0f); shv[j][h] = *(const f32x4*)(w.mods + b * NMOD + k); }
        for (int r4 = 0; r4 < 16; r4 += 4) {
            f32x4 v[4][2][2];
#pragma unroll
            for (int r = 0; r < 4; ++r)
#pragma unroll
                for (int j = 0; j < 2; ++j) { const float* xr = a.in[0] + (size_t)(m0 + r4 + r) * D + j * 512 + F.lane * 8; v[r][j][0] = *(const f32x4*)xr; v[r][j][1] = *(const f32x4*)(xr + 4); }
#pragma unroll
            for (int r = 0; r < 4; ++r) { float s = 0.f;
#pragma unroll
                for (int j = 0; j < 2; ++j) { const f32x4 v0 = v[r][j][0], v1 = v[r][j][1];
                    s += (v0[0] * v0[0] + v0[1] * v0[1]) + (v0[2] * v0[2] + v0[3] * v0[3]) + (v1[0] * v1[0] + v1[1] * v1[1]) + (v1[2] * v1[2] + v1[3] * v1[3]); }
                s = wave_sum(s); const float rs = __builtin_amdgcn_rsqf(s * (1.0f / D) + EPS);
#pragma unroll
                for (int j = 0; j < 2; ++j) { const f32x4 a0 = v[r][j][0] * rs * gsv[j][0] + shv[j][0], a1 = v[r][j][1] * rs * gsv[j][1] + shv[j][1];
                    *(u32x4*)(w.XN + (size_t)(m0 + r4 + r) * D + j * 512 + F.lane * 8) = (u32x4){cvt_pk_bf16(a0[0], a0[1]), cvt_pk_bf16(a0[2], a0[3]), cvt_pk_bf16(a1[0], a1[1]), cvt_pk_bf16(a1[2], a1[3])}; } }
        }
    }
}
__device__ __forceinline__ void p1_phase(const Frame& F, const Args& a, const WsPtrs& w) {
    xpass(F, a, w);
    const int gw = F.vcu * NWAVES + F.wave, NGW = F.G * NWAVES;
    constexpr int I1 = NGU / 16, I2 = NIN / 16;
    for (int it = gw; it < I1 + I2; it += NGW) {
        if (it < I2) p1_cb_item(F, w.mods + 3 * D, w.WIN, NIN, w.cb2, it);
        else p1_cb_item(F, w.mods + 6 * D, w.WGU2, NGU, w.cb3, it - I2);
    }
}
__device__ __forceinline__ void cb3_items(const Frame& F, const WsPtrs& w) {
    const int gw = F.vcu * NWAVES + F.wave, NGW = F.G * NWAVES;
    for (int it = gw; it < NGU / 16; it += NGW) p1_cb_item(F, w.mods + 6 * D, w.WGU2, NGU, w.cb3, it);
}

__global__ void k_vln(const bf16_t* P, const float* g, const float* bta, bf16_t* vn) {
    const int m = (blockIdx.x * blockDim.x + threadIdx.x) >> 6, lane = threadIdx.x & 63;
    if (m >= M) return;
    float v[8], s = 0.f;
    for (int i = 0; i < 8; ++i) { v[i] = bf2f(P[(size_t)m * NIN + PC_V + i * 64 + lane]); s += v[i]; }
    for (int o = 1; o < 64; o <<= 1) s += __shfl_xor(s, o);
    const float mu = s * (1.0f / DA); float q = 0.f;
    for (int i = 0; i < 8; ++i) { v[i] -= mu; q += v[i] * v[i]; }
    for (int o = 1; o < 64; o <<= 1) q += __shfl_xor(q, o);
    const float rs = rsqrtf(q * (1.0f / DA) + EPS);
    for (int i = 0; i < 8; ++i) { const int c = i * 64 + lane; vn[(size_t)m * DA + c] = f2bf(v[i] * rs * g[c] + bta[c]); }
}
__global__ void k_sgu(const bf16_t* P, const bf16_t* vn, const bf16_t* wsp, const float* bsp, bf16_t* mix) {
    const int ch = threadIdx.x + (blockIdx.x & 1) * 256, m = blockIdx.x >> 1;
    const int t = m & 127, g = ch >> 7, m0 = m - t;
    float z = 0.f;
    for (int s = 0; s <= t; ++s) z += bf2f(wsp[(g * 128 + t) * 128 + s]) * bf2f(vn[(size_t)(m0 + s) * DA + ch]);
    z += bsp[g * 128 + t];
    mix[(size_t)m * D + ch] = f2bf(bf2f(P[(size_t)m * NIN + PC_U + ch]) * z);
}
__global__ __launch_bounds__(128) void k_attn(const bf16_t* P, const float* gq, const float* gk, const float* sinks, bf16_t* mix) {
    const int i = threadIdx.x, hq = blockIdx.x & 7, n = (blockIdx.x >> 3) & 15, b = blockIdx.x >> 7, h = hq >> 2;
    const int m = b * SEQ + n * 128 + i;
    float q[64], o[64]; float s2 = 0.f;
    for (int d = 0; d < 64; ++d) { q[d] = bf2f(P[(size_t)m * NIN + PC_Q + hq * 64 + d]); s2 += q[d] * q[d]; o[d] = 0.f; }
    const float qs = rsqrtf(s2 * (1.0f / 64) + EPS) * 0.125f;
    for (int d = 0; d < 64; ++d) q[d] *= qs * gq[d];
    const float sink = sinks[hq];
    float mx = sink, l = 1.0f;
    for (int dj = 127; dj >= 0; --dj) {
        const int kp = n * 128 + i - dj; if (kp < 0) continue;
        const bf16_t* kr = P + (size_t)(b * SEQ + kp) * NIN + PC_K + h * 64;
        float kk[64], k2 = 0.f;
        for (int d = 0; d < 64; ++d) { kk[d] = bf2f(kr[d]); k2 += kk[d] * kk[d]; }
        const float ks = rsqrtf(k2 * (1.0f / 64) + EPS); float sc = 0.f;
        for (int d = 0; d < 64; ++d) sc += q[d] * kk[d] * gk[d];
        sc *= ks;
        const float nm = fmaxf(mx, sc), f = __expf(mx - nm), p = __expf(sc - nm);
        const bf16_t* vr = P + (size_t)(b * SEQ + kp) * NIN + PC_VV + h * 64;
        for (int d = 0; d < 64; ++d) o[d] = o[d] * f + p * bf2f(vr[d]);
        l = l * f + p; mx = nm;
    }
    const float il = 1.0f / l;
    for (int d = 0; d < 64; ++d) mix[(size_t)m * D + 512 + hq * 64 + d] = f2bf(o[d] * il);
}


typedef short s16x4 __attribute__((ext_vector_type(4)));
typedef short v4i16_t __attribute__((ext_vector_type(4)));
__device__ __forceinline__ s16x4 vtr(const LAS unsigned char* p) { return __builtin_bit_cast(s16x4, __builtin_amdgcn_ds_read_tr16_b64_v4i16((LAS v4i16_t*)p)); }
__device__ __forceinline__ bf16x8 cat4(s16x4 a, s16x4 b) { return (bf16x8){a[0], a[1], a[2], a[3], b[0], b[1], b[2], b[3]}; }
__device__ __forceinline__ void unpack8(const u32x4 v, float (&f)[8]) { f[0] = bflo(v[0]); f[1] = bfhi(v[0]); f[2] = bflo(v[1]); f[3] = bfhi(v[1]); f[4] = bflo(v[2]); f[5] = bfhi(v[2]); f[6] = bflo(v[3]); f[7] = bfhi(v[3]); }

constexpr int ATT_K_OFF = 0, ATT_V_OFF = 32768;
static_assert(4 * 128 * 256 <= RING_BYTES, "mixer LDS");

struct KVRaw { u32x4 k[4], v[4]; };
__device__ __forceinline__ void attn_load_kv(KVRaw& r, const Frame& F, const bf16_t* P, int b, int n, int h) {
    const int ch = F.tid & 7;
#pragma unroll
    for (int it = 0; it < 4; ++it) {
        const int j = (F.tid >> 3) + 64 * it, kp = (n - 1) * 128 + j;
        r.k[it] = (u32x4){0u, 0u, 0u, 0u}; r.v[it] = (u32x4){0u, 0u, 0u, 0u};
        if (kp >= 0) { const bf16_t* rowp = P + (size_t)(b * SEQ + kp) * NIN; r.k[it] = *(const u32x4*)(rowp + PC_K + h * 64 + ch * 8); r.v[it] = *(const u32x4*)(rowp + PC_VV + h * 64 + ch * 8); }
    }
}
__device__ __forceinline__ void attn_unit(const Frame& F, const bf16_t* P, bf16_t* MIX, const float* gq, const float* gk, const float* sinks, int b, int n, int h, KVRaw& raw, bool has_next, int nb, int nn, int nh) {
    const int lane = F.lane, w = F.wave, r = lane & 15, g = lane >> 4;
    LAS unsigned char* Kt = F.lds + RING_OFF + ATT_K_OFF; LAS unsigned char* Vt = F.lds + RING_OFF + ATT_V_OFF;
    const int qrow = b * SEQ + n * 128 + 16 * w + r;
    u32x4 qraw[4][2];
#pragma unroll
    for (int hh = 0; hh < 4; ++hh) { const bf16_t* qp = P + (size_t)qrow * NIN + PC_Q + (4 * h + hh) * 64; qraw[hh][0] = *(const u32x4*)(qp + 8 * g); qraw[hh][1] = *(const u32x4*)(qp + 32 + 8 * g); }
    {
        const int ch = F.tid & 7;
        const f32x4 gk0 = *(const f32x4*)(gk + ch * 8), gk1 = *(const f32x4*)(gk + ch * 8 + 4);
#pragma unroll
        for (int it = 0; it < 4; ++it) {
            const int j = (F.tid >> 3) + 64 * it;
            float kf[8]; unpack8(raw.k[it], kf);
            float ss = (kf[0] * kf[0] + kf[1] * kf[1]) + (kf[2] * kf[2] + kf[3] * kf[3]) + (kf[4] * kf[4] + kf[5] * kf[5]) + (kf[6] * kf[6] + kf[7] * kf[7]);
            ss += __shfl_xor(ss, 1); ss += __shfl_xor(ss, 2); ss += __shfl_xor(ss, 4);
            const float rs = __builtin_amdgcn_rsqf(ss * (1.0f / HD) + EPS);
            const u32x4 kn = (u32x4){cvt_pk_bf16(kf[0] * rs * gk0[0], kf[1] * rs * gk0[1]), cvt_pk_bf16(kf[2] * rs * gk0[2], kf[3] * rs * gk0[3]),
                                     cvt_pk_bf16(kf[4] * rs * gk1[0], kf[5] * rs * gk1[1]), cvt_pk_bf16(kf[6] * rs * gk1[2], kf[7] * rs * gk1[3])};
            *(LAS u32x4*)(Kt + j * 128 + 16 * (ch ^ (j & 7))) = kn;
            const int x = (j >> 1) & 3; const u32x4 vv = raw.v[it];
            *(LAS u32x4*)(Vt + j * 128 + 16 * (ch ^ (x >> 1))) = (x & 1) ? (u32x4){vv[2], vv[3], vv[0], vv[1]} : vv;
        }
    }
    __syncthreads();
    if (has_next) attn_load_kv(raw, F, P, nb, nn, nh);
    const int q4 = (lane & 15) >> 2, p4 = lane & 3;
    const int vx = (2 * g + (q4 >> 1)) & 3;
#pragma unroll
    for (int hh = 0; hh < 4; ++hh) {
        const int hq = 4 * h + hh;
        bf16x8 qa0, qa1;
        {
            float a[8], c[8]; unpack8(qraw[hh][0], a); unpack8(qraw[hh][1], c);
            float ss = 0.f;
#pragma unroll
            for (int i = 0; i < 8; ++i) ss += a[i] * a[i] + c[i] * c[i];
            ss += __shfl_xor(ss, 16); ss += __shfl_xor(ss, 32);
            const float qs = __builtin_amdgcn_rsqf(ss * (1.0f / HD) + EPS) * (0.125f * LOG2E);
            const f32x4 ga0 = *(const f32x4*)(gq + 8 * g), ga1 = *(const f32x4*)(gq + 8 * g + 4), gc0 = *(const f32x4*)(gq + 32 + 8 * g), gc1 = *(const f32x4*)(gq + 32 + 8 * g + 4);
            const u32x4 p0 = (u32x4){cvt_pk_bf16(a[0] * qs * ga0[0], a[1] * qs * ga0[1]), cvt_pk_bf16(a[2] * qs * ga0[2], a[3] * qs * ga0[3]), cvt_pk_bf16(a[4] * qs * ga1[0], a[5] * qs * ga1[1]), cvt_pk_bf16(a[6] * qs * ga1[2], a[7] * qs * ga1[3])};
            const u32x4 p1 = (u32x4){cvt_pk_bf16(c[0] * qs * gc0[0], c[1] * qs * gc0[1]), cvt_pk_bf16(c[2] * qs * gc0[2], c[3] * qs * gc0[3]), cvt_pk_bf16(c[4] * qs * gc1[0], c[5] * qs * gc1[1]), cvt_pk_bf16(c[6] * qs * gc1[2], c[7] * qs * gc1[3])};
            qa0 = __builtin_bit_cast(bf16x8, p0); qa1 = __builtin_bit_cast(bf16x8, p1);
        }
        f32x4 sacc[10];
#pragma unroll
        for (int fp = 0; fp < 9; ++fp) {
            const int f = (w + fp) < 16 ? (w + fp) : 15; const LAS unsigned char* kr = Kt + (16 * f + r) * 128;
            const bf16x8 k0 = *(const LAS bf16x8*)(kr + 16 * (g ^ (r & 7))), k1 = *(const LAS bf16x8*)(kr + 16 * ((4 + g) ^ (r & 7)));
            sacc[fp] = __builtin_amdgcn_mfma_f32_16x16x32_bf16(k0, qa0, (f32x4){0.f, 0.f, 0.f, 0.f}, 0, 0, 0);
            sacc[fp] = __builtin_amdgcn_mfma_f32_16x16x32_bf16(k1, qa1, sacc[fp], 0, 0, 0);
        }
        const float sink2 = sinks[hq] * LOG2E;
        float mx = sink2;
#pragma unroll
        for (int fp = 0; fp < 9; ++fp) {
            const bool fvalid = (n > 0) || (w + fp >= 8);
#pragma unroll
            for (int e = 0; e < 4; ++e) { const int rel = 16 * fp + 4 * g + e - r;
                const bool valid = fvalid && (fp == 0 ? (rel >= 1) : (fp == 8 ? (rel <= 128) : true));
                const float t = valid ? sacc[fp][e] : -INFINITY; sacc[fp][e] = t; mx = fmaxf(mx, t); } }
        mx = fmaxf(mx, __shfl_xor(mx, 16)); mx = fmaxf(mx, __shfl_xor(mx, 32));
        float l = 0.f;
#pragma unroll
        for (int fp = 0; fp < 9; ++fp)
#pragma unroll
            for (int e = 0; e < 4; ++e) { const float p = __builtin_amdgcn_exp2f(sacc[fp][e] - mx); sacc[fp][e] = p; l += p; }
        sacc[9] = (f32x4){0.f, 0.f, 0.f, 0.f};
        l += __shfl_xor(l, 16); l += __shfl_xor(l, 32);
        l += __builtin_amdgcn_exp2f(sink2 - mx);
        const float inv = __builtin_amdgcn_rcpf(l);
        f32x4 oacc[4];
#pragma unroll
        for (int df = 0; df < 4; ++df) oacc[df] = (f32x4){0.f, 0.f, 0.f, 0.f};
#pragma unroll
        for (int s = 0; s < 5; ++s) {
            const u32x4 pw = (u32x4){cvt_pk_bf16(sacc[2 * s][0], sacc[2 * s][1]), cvt_pk_bf16(sacc[2 * s][2], sacc[2 * s][3]), cvt_pk_bf16(sacc[2 * s + 1][0], sacc[2 * s + 1][1]), cvt_pk_bf16(sacc[2 * s + 1][2], sacc[2 * s + 1][3])};
            const bf16x8 pb = __builtin_bit_cast(bf16x8, pw);
            s16x4 vt[2][4];
#pragma unroll
            for (int t = 0; t < 2; ++t) { const int f = (w + 2 * s + t) < 16 ? (w + 2 * s + t) : 15;
                const LAS unsigned char* vr = Vt + (16 * f + 4 * g + q4) * 128;
#pragma unroll
                for (int df = 0; df < 4; ++df) vt[t][df] = vtr(vr + 8 * ((4 * p4 + df) ^ vx)); }
#pragma unroll
            for (int df = 0; df < 4; ++df) oacc[df] = __builtin_amdgcn_mfma_f32_16x16x32_bf16(cat4(vt[0][df], vt[1][df]), pb, oacc[df], 0, 0, 0);
        }
        bf16_t* op = MIX + (size_t)qrow * D + 512 + hq * 64 + 16 * g;
        const u32x4 o0 = (u32x4){cvt_pk_bf16(oacc[0][0] * inv, oacc[0][1] * inv), cvt_pk_bf16(oacc[0][2] * inv, oacc[0][3] * inv), cvt_pk_bf16(oacc[1][0] * inv, oacc[1][1] * inv), cvt_pk_bf16(oacc[1][2] * inv, oacc[1][3] * inv)};
        const u32x4 o1 = (u32x4){cvt_pk_bf16(oacc[2][0] * inv, oacc[2][1] * inv), cvt_pk_bf16(oacc[2][2] * inv, oacc[2][3] * inv), cvt_pk_bf16(oacc[3][0] * inv, oacc[3][1] * inv), cvt_pk_bf16(oacc[3][2] * inv, oacc[3][3] * inv)};
        *(u32x4*)op = o0; *(u32x4*)(op + 8) = o1;
    }
    __syncthreads();
}

__device__ __forceinline__ void sgu_unit(const Frame& F, const bf16_t* P, bf16_t* MIX, const bf16_t* WSP, const float* gln, const float* bln, const float* bsp, int b, int n, unsigned char* g_ws_) {
    const int lane = F.lane, w = F.wave, gq = lane >> 4;
    LAS unsigned char* Vn = F.lds + RING_OFF;
    const int row0 = b * SEQ + n * 128;
    {
        const f32x4 g0 = *(const f32x4*)(gln + lane * 8), g1 = *(const f32x4*)(gln + lane * 8 + 4), b0 = *(const f32x4*)(bln + lane * 8), b1 = *(const f32x4*)(bln + lane * 8 + 4);
        u32x4 xv[16];
#pragma unroll
        for (int rr = 0; rr < 16; ++rr) xv[rr] = *(const u32x4*)(P + (size_t)(row0 + 16 * w + rr) * NIN + PC_V + lane * 8);
        float red[16];
#pragma unroll
        for (int rr = 0; rr < 16; ++rr) red[rr] = ((bflo(xv[rr][0]) + bfhi(xv[rr][0])) + (bflo(xv[rr][1]) + bfhi(xv[rr][1]))) + ((bflo(xv[rr][2]) + bfhi(xv[rr][2])) + (bflo(xv[rr][3]) + bfhi(xv[rr][3])));
#define SGU_TREDUCE(v) do { \
        _Pragma("unroll") for (int i = 0; i < 8; ++i) { const bool hi_ = lane & 1; const float keep = hi_ ? v[2 * i + 1] : v[2 * i], send = hi_ ? v[2 * i] : v[2 * i + 1]; v[i] = keep + __shfl_xor(send, 1); } \
        _Pragma("unroll") for (int i = 0; i < 4; ++i) { const bool hi_ = lane & 2; const float keep = hi_ ? v[2 * i + 1] : v[2 * i], send = hi_ ? v[2 * i] : v[2 * i + 1]; v[i] = keep + __shfl_xor(send, 2); } \
        _Pragma("unroll") for (int i = 0; i < 2; ++i) { const bool hi_ = lane & 4; const float keep = hi_ ? v[2 * i + 1] : v[2 * i], send = hi_ ? v[2 * i] : v[2 * i + 1]; v[i] = keep + __shfl_xor(send, 4); } \
        { const bool hi_ = lane & 8; const float keep = hi_ ? v[1] : v[0], send = hi_ ? v[0] : v[1]; v[0] = keep + __shfl_xor(send, 8); } \
        v[0] += __shfl_xor(v[0], 16); v[0] += __shfl_xor(v[0], 32); } while (0)
        SGU_TREDUCE(red);
        const float mu_l = red[0] * (1.0f / DA);
#pragma unroll
        for (int rr = 0; rr < 16; ++rr) { float q = 0.f; const float m_ = __shfl(mu_l, rr);
#pragma unroll
            for (int i = 0; i < 4; ++i) { const float d0 = bflo(xv[rr][i]) - m_, d1 = bfhi(xv[rr][i]) - m_; q += d0 * d0 + d1 * d1; }
            red[rr] = q; }
        SGU_TREDUCE(red);
#undef SGU_TREDUCE
        const float rs_l = __builtin_amdgcn_rsqf(red[0] * (1.0f / DA) + EPS);
        const int q = lane >> 4, c = lane & 15;
#pragma unroll
        for (int rr = 0; rr < 16; ++rr) {
            const float rs = __shfl(rs_l, rr), m_ = __shfl(mu_l, rr); const int s = 16 * w + rr;
            const unsigned o0 = cvt_pk_bf16((bflo(xv[rr][0]) - m_) * rs * g0[0] + b0[0], (bfhi(xv[rr][0]) - m_) * rs * g0[1] + b0[1]);
            const unsigned o1 = cvt_pk_bf16((bflo(xv[rr][1]) - m_) * rs * g0[2] + b0[2], (bfhi(xv[rr][1]) - m_) * rs * g0[3] + b0[3]);
            const unsigned o2 = cvt_pk_bf16((bflo(xv[rr][2]) - m_) * rs * g1[0] + b1[0], (bfhi(xv[rr][2]) - m_) * rs * g1[1] + b1[1]);
            const unsigned o3 = cvt_pk_bf16((bflo(xv[rr][3]) - m_) * rs * g1[2] + b1[2], (bfhi(xv[rr][3]) - m_) * rs * g1[3] + b1[3]);
            const int x = (s & 3) | (((s >> 3) & 1) << 2);
            *(LAS u32x4*)(Vn + q * 32768 + s * 256 + 16 * (c ^ (x >> 1))) = (x & 1) ? (u32x4){o2, o3, o0, o1} : (u32x4){o0, o1, o2, o3};
        }
    }
    __syncthreads(); STAMP(2);
    int lane_ = lane; asm volatile("" : "+v"(lane_));
    const int q4 = (lane_ & 15) >> 2, p4 = lane_ & 3;
    const int vx = q4 | ((gq & 1) << 2);
    bf16x8 wbn[4]; u32x4 uvn[4]; float biasn;
#define SGU_TB(G) (((G) < 2) ? w : 7 - w)
#define SGU_LOAD(G) do { const int t_ = 16 * SGU_TB(G) + (lane_ & 15); const bf16_t* wrow_ = WSP + (size_t)((G) * 128 + t_) * 128 + 8 * gq; const bf16_t* up_ = P + (size_t)(row0 + t_) * NIN + PC_U + (G) * 128 + 32 * gq; \
        _Pragma("unroll") for (int k = 0; k < 4; ++k) { wbn[k] = *(const bf16x8*)(wrow_ + 32 * k); uvn[k] = *(const u32x4*)(up_ + 8 * k); } biasn = bsp[(G) * 128 + t_]; } while (0)
    SGU_LOAD(0);
#pragma unroll
    for (int g = 0; g < NG; ++g) {
        f32x4 z[8];
#pragma unroll
        for (int cf = 0; cf < 8; ++cf) z[cf] = (f32x4){0.f, 0.f, 0.f, 0.f};
        bf16x8 wb[4]; u32x4 uv[4];
#pragma unroll
        for (int k = 0; k < 4; ++k) { wb[k] = wbn[k]; uv[k] = uvn[k]; }
        const float bias = biasn; const int tb = SGU_TB(g), t = 16 * tb + (lane_ & 15);
        if (g + 1 < NG) SGU_LOAD(g + 1);
#pragma unroll
        for (int ks = 0; ks < 4; ++ks) {
            if (ks <= (tb >> 1)) {
                s16x4 vt[2][8];
#pragma unroll
                for (int t2 = 0; t2 < 2; ++t2) { const LAS unsigned char* vr = Vn + g * 32768 + (32 * ks + 8 * gq + 4 * t2 + q4) * 256;
#pragma unroll
                    for (int cf = 0; cf < 8; ++cf) vt[t2][cf] = vtr(vr + 8 * ((8 * p4 + cf) ^ vx)); }
#pragma unroll
                for (int cf = 0; cf < 8; ++cf) z[cf] = __builtin_amdgcn_mfma_f32_16x16x32_bf16(cat4(vt[0][cf], vt[1][cf]), wb[ks], z[cf], 0, 0, 0);
            }
        }
        bf16_t* op = MIX + (size_t)(row0 + t) * D + g * 128 + 32 * gq;
#pragma unroll
        for (int k = 0; k < 4; ++k) {
            float uf[8]; unpack8(uv[k], uf);
            const f32x4 za = z[2 * k] + bias, zb = z[2 * k + 1] + bias;
            *(u32x4*)(op + 8 * k) = (u32x4){cvt_pk_bf16(uf[0] * za[0], uf[1] * za[1]), cvt_pk_bf16(uf[2] * za[2], uf[3] * za[3]), cvt_pk_bf16(uf[4] * zb[0], uf[5] * zb[1]), cvt_pk_bf16(uf[6] * zb[2], uf[7] * zb[3])};
        }
    }
#undef SGU_LOAD
#undef SGU_TB
    STAMP(3);
    __syncthreads();
}

__device__ __forceinline__ void mixer_phase(const Frame& F, const Args& a, const WsPtrs& w) {
    unsigned char* g_ws_ = a.ws; (void)g_ws_; STAMP(0);
    constexpr int NATT = BATCH * NCH * NKVH, NSGU = BATCH * NCH;
    {
        KVRaw raw;
        int u = F.vcu;
        if (u < NATT) attn_load_kv(raw, F, w.P, u >> 5, (u >> 1) & 15, u & 1);
        for (; u < NATT; u += F.G) {
            const int un = u + F.G; const bool has_next = un < NATT;
            attn_unit(F, w.P, w.MIX, a.in[14], a.in[15], a.in[16], u >> 5, (u >> 1) & 15, u & 1, raw, has_next, un >> 5, (un >> 1) & 15, un & 1);
        }
    }
    STAMP(1);
    for (int u = F.vcu; u < NSGU; u += F.G) sgu_unit(F, w.P, w.MIX, w.WSP, a.in[10], a.in[11], a.in[13], u >> 4, u & 15, a.ws);
    STAMP(4);
}

__global__ void __launch_bounds__(NWAVES * 64, 2) mega_fwd(Args args) {
    extern __shared__ __attribute__((aligned(16))) unsigned char lds[];
    Frame F;
    F.lds = (LAS unsigned char*)lds;
    F.MISC = (volatile LAS unsigned*)(F.lds + MISC_OFF);
    F.tid = threadIdx.x; F.lane = F.tid & 63; F.wave = __builtin_amdgcn_readfirstlane(F.tid >> 6);
    F.G = gridDim.x; { const int bx = blockIdx.x; F.vcu = (F.G % 8 == 0) ? (bx % 8) * (F.G / 8) + bx / 8 : bx; }
    unsigned char* ws = args.ws;
    WsPtrs w;
    w.mods = (float*)(ws + WS_MODS); w.cb1 = (float*)(ws + WS_CB1); w.cb2 = (float*)(ws + WS_CB2); w.cb3 = (float*)(ws + WS_CB3);
    w.ss1 = (float*)(ws + WS_SS1); w.ss2 = (float*)(ws + WS_SS2); w.ss3 = (float*)(ws + WS_SS3);
    w.WGU1 = (bf16_t*)(ws + WS_WGU1); w.WD1 = (bf16_t*)(ws + WS_WD1); w.WIN = (bf16_t*)(ws + WS_WIN); w.WA = (bf16_t*)(ws + WS_WA); w.WB = (bf16_t*)(ws + WS_WB);
    w.WO = (bf16_t*)(ws + WS_WO); w.WGU2 = (bf16_t*)(ws + WS_WGU2); w.WD2 = (bf16_t*)(ws + WS_WD2); w.WSP = (bf16_t*)(ws + WS_WSP);
    w.XN = (bf16_t*)(ws + WS_XN); w.MIX = (bf16_t*)(ws + WS_MIX); w.MERGED = (bf16_t*)(ws + WS_MERGED); w.ACT = (bf16_t*)(ws + WS_ACT); w.P = (bf16_t*)(ws + WS_P);
    for (int u = F.tid; u < (LDS_BYTES - LDSCTL_OFF) / 4; u += NWAVES * 64) ((LAS unsigned*)(F.lds + LDSCTL_OFF))[u] = 0u;
    __syncthreads();
    XcdBarrier bar = xcd_barrier_post((unsigned*)(ws + WS_CTL) + CW_BAR + args.li * XCD_BAR_WORDS, F.MISC + 8);
    const int lo = args.ph_lo, hi = args.ph_hi;
#define IN(k) (lo <= (k) && (k) < hi)
#ifdef PROBE_WORK
#define SEAM(k) do { if ((k) == PROBE_LO) epi_ticks = __builtin_amdgcn_s_memrealtime() - pr_t0; if (IN(k) && IN((k) + 1)) xcd_barrier(bar); } while (0)
#else
#define SEAM(k) do { if (IN(k) && IN((k) + 1)) xcd_barrier(bar); } while (0)
#endif
    const int cid = (int)blockIdx.x;
    float* out = args.out;
    unsigned long long epi_ticks = 0;
#ifdef PROBE_LO
    unsigned long long pr_t0 = 0, pr_t1 = 0;
#ifdef PROBE_CLOCK
    unsigned long long pr_c0 = 0, pr_c1 = 0;
#define PR_BEGIN(k) do { if ((k) == PROBE_LO) { pr_t0 = __builtin_amdgcn_s_memrealtime(); pr_c0 = __builtin_amdgcn_s_memtime(); } } while (0)
#else
#define PR_BEGIN(k) do { if ((k) == PROBE_LO) { pr_t0 = __builtin_amdgcn_s_memrealtime(); epi_ticks = 0; } } while (0)
#endif
#ifdef PROBE_CLOCK
#define PR_END(k) do { if ((k) == PROBE_HI) { pr_c1 = __builtin_amdgcn_s_memtime(); pr_t1 = __builtin_amdgcn_s_memrealtime(); pr_t1 = pr_t0 + (unsigned long long)((double)(pr_c1 - pr_c0) / (double)(pr_t1 - pr_t0) * 10000.0); } } while (0)
#elif defined(PROBE_RED)
#define PR_END(k) do { if ((k) == PROBE_HI && F.tid == 0) { atomicMax((unsigned*)(ws + WS_CTL) + 64, (unsigned)epi_ticks); atomicAdd((unsigned*)(ws + WS_CTL) + 65, (unsigned)epi_ticks); } } while (0)
#elif defined(PROBE_EPI)
#define PR_END(k) do { if ((k) == PROBE_HI) { pr_t1 = pr_t0 + epi_ticks; } } while (0)
#else
#define PR_END(k) do { if ((k) == PROBE_HI) pr_t1 = __builtin_amdgcn_s_memrealtime(); } while (0)
#endif
#else
#define PR_BEGIN(k) do {} while (0)
#define PR_END(k) do {} while (0)
#endif

    if (IN(0)) { PR_BEGIN(0); p0_prologue(F, args, w); SEAM(0); PR_END(0); }
    if (IN(1)) { PR_BEGIN(1); p1_phase(F, args, w); SEAM(1); PR_END(1); }
    if (IN(2)) { PR_BEGIN(2);
        pg8::Gemm g{w.XN, w.XN, w.WGU1, w.WGU1, D, D, D}; pg8::StaticOrder S; S.init(M, NGU, F.G, cid);
        EpiGU<true> E{w.ACT, nullptr, nullptr};
        pg8::gemm_phase(F.lds + RING_OFF, g, S, E, epi_ticks); SEAM(2); PR_END(2);
    }
    if (IN(3)) { PR_BEGIN(3);
        pg8::Gemm g{w.ACT, w.ACT, w.WD1, w.WD1, FF, FF, FF}; pg8::StaticOrder S; S.init(M, D, F.G, cid);
        EpiRes<true> E{args.in[0], out, w.mods + 2 * D, args.in[8], w.mods + 4 * D, w.XN, w.ss2, (LAS float*)(F.lds + RED_OFF), 0.5f};
#ifdef PROBE_SKEW
        if (blockIdx.x & 1) { const unsigned long long t0_ = __builtin_amdgcn_s_memrealtime(); while (__builtin_amdgcn_s_memrealtime() - t0_ < (unsigned long long)(PROBE_SKEW * 100)) __builtin_amdgcn_s_sleep(8); }
#endif
        pg8::gemm_phase(F.lds + RING_OFF, g, S, E, epi_ticks); SEAM(3); PR_END(3);
    }
    if (IN(4)) { PR_BEGIN(4);
        pg8::Gemm g{w.XN, w.XN, w.WIN, w.WIN, D, D, D}; pg8::StaticOrder S; S.init(M, NIN, F.G, cid);
        EpiWin E{w.P, w.ss2, w.cb2};
        pg8::gemm_phase(F.lds + RING_OFF, g, S, E, epi_ticks);
        SEAM(4); PR_END(4);
    }
    if (IN(5)) { PR_BEGIN(5);
        mixer_phase(F, args, w);
        SEAM(5); PR_END(5);
#ifdef PROBE_STAMPS
        if (blockIdx.x == 0 && F.tid == 0) { const unsigned long long* st_ = (const unsigned long long*)(ws + WS_CTL) + 40; pr_t0 = st_[PROBE_SA]; pr_t1 = st_[PROBE_SB]; }
#endif
    }
    if (IN(6)) { PR_BEGIN(6);
        pg8::Gemm g{w.MIX, w.MIX + 512, w.WA, w.WB, D, DA, DA}; pg8::StaticOrder S; S.init(M, D, F.G, cid, 2);
        EpiBranch E{w.P, w.MERGED};
        pg8::gemm_phase(F.lds + RING_OFF, g, S, E, epi_ticks); SEAM(6); PR_END(6);
    }
    if (IN(7)) { PR_BEGIN(7);
        pg8::Gemm g{w.MERGED, w.MERGED, w.WO, w.WO, D, D, D}; pg8::StaticOrder S; S.init(M, D, F.G, cid);
        EpiRes<true> E{out, out, w.mods + 5 * D, args.in[20], w.mods + 7 * D, w.XN, w.ss3, (LAS float*)(F.lds + RED_OFF), 1.0f};
        pg8::gemm_phase(F.lds + RING_OFF, g, S, E, epi_ticks); SEAM(7); PR_END(7);
    }
    if (IN(8)) { PR_BEGIN(8);
        pg8::Gemm g{w.XN, w.XN, w.WGU2, w.WGU2, D, D, D}; pg8::StaticOrder S; S.init(M, NGU, F.G, cid);
        EpiGU<false> E{w.ACT, w.ss3, w.cb3};
        pg8::gemm_phase(F.lds + RING_OFF, g, S, E, epi_ticks); SEAM(8); PR_END(8);
    }
    if (IN(9)) { PR_BEGIN(9);
        pg8::Gemm g{w.ACT, w.ACT, w.WD2, w.WD2, FF, FF, FF}; pg8::StaticOrder S; S.init(M, D, F.G, cid);
        EpiRes<false> E{out, out, w.mods + 8 * D, nullptr, nullptr, nullptr, nullptr, nullptr, 0.5f};
        pg8::gemm_phase(F.lds + RING_OFF, g, S, E, epi_ticks);
#ifdef PROBE_LO
        xcd_barrier(bar); PR_END(9);
#ifdef PROBE_RED
        xcd_barrier(bar);
        if (blockIdx.x == 0 && F.tid == 0) { const unsigned mx_ = __hip_atomic_load((unsigned*)(ws + WS_CTL) + 64, RLX_AGENT), sm_ = __hip_atomic_load((unsigned*)(ws + WS_CTL) + 65, RLX_AGENT);
            pr_t0 = 0; pr_t1 = (PROBE_RED == 1) ? mx_ : sm_ / gridDim.x; }
#endif
        if (blockIdx.x == 0 && F.tid == 0) out[0] += PROBE_Q * floorf(((float)(pr_t1 - pr_t0) * 0.01f + PROBE_OFF) * (1.0f / PROBE_Q));
#endif
    }
#undef IN
#undef SEAM
}

extern "C" void kernel_launch(void* const* d_in, const int* in_sizes, int n_in, void* d_out, int out_size, void* d_ws, size_t ws_size, hipStream_t stream) {
    static int grid = 0;
    if (grid == 0) {
        if (n_in != 24 || in_sizes[0] != M * D || out_size != M * D || ws_size < WS_END) {
            fprintf(stderr, "kernel_launch: unexpected shapes (n_in %d, in0 %d, out %d, ws %zu < %zu); nothing launched\n", n_in, n_in > 0 ? in_sizes[0] : -1, out_size, ws_size, (size_t)WS_END); grid = -1; return; }
        int dev = 0, cus = 0, per_cu = 0;
        if (hipGetDevice(&dev) != hipSuccess || hipDeviceGetAttribute(&cus, hipDeviceAttributeMultiprocessorCount, dev) != hipSuccess) { fprintf(stderr, "kernel_launch: device query failed\n"); grid = -1; return; }
        if (hipFuncSetAttribute((const void*)mega_fwd, hipFuncAttributeMaxDynamicSharedMemorySize, LDS_BYTES) != hipSuccess) { fprintf(stderr, "kernel_launch: hipFuncSetAttribute failed\n"); grid = -1; return; }
        if (hipOccupancyMaxActiveBlocksPerMultiprocessor(&per_cu, (const void*)mega_fwd, NWAVES * 64, LDS_BYTES) != hipSuccess || per_cu < 1) {
            fprintf(stderr, "kernel_launch: occupancy query reports %d workgroups per CU; nothing launched\n", per_cu); (void)hipGetLastError(); grid = -1; return; }
        grid = cus;
        fprintf(stderr, "kernel_launch: grid %d (occupancy query: %d per CU)\n", grid, per_cu);
    }
    if (grid < 0) return;
    (void)hipMemsetAsync((char*)d_ws + WS_CTL, 0, CTL_BYTES, stream);
    Args a; memset(&a, 0, sizeof a);
    for (int i = 0; i < 24; ++i) a.in[i] = (const float*)d_in[i];
    a.out = (float*)d_out; a.ws = (unsigned char*)d_ws;
#if N_LAUNCHES == 1
    a.ph_lo = 0; a.ph_hi = 10; a.li = 0;
    hipLaunchKernelGGL(mega_fwd, dim3(grid), dim3(NWAVES * 64), LDS_BYTES, stream, a);
#else
    a.ph_lo = 0; a.ph_hi = 5; a.li = 0;
    hipLaunchKernelGGL(mega_fwd, dim3(grid), dim3(NWAVES * 64), LDS_BYTES, stream, a);
    {
        unsigned char* ws = (unsigned char*)d_ws; const float* const* in = (const float* const*)d_in;
        bf16_t* P = (bf16_t*)(ws + WS_P); bf16_t* MIX = (bf16_t*)(ws + WS_MIX); bf16_t* VN = (bf16_t*)(ws + WS_MERGED); bf16_t* WSP = (bf16_t*)(ws + WS_WSP);
        k_vln<<<M / 4, 256, 0, stream>>>(P, in[10], in[11], VN);
        k_sgu<<<M * 2, 256, 0, stream>>>(P, VN, WSP, in[13], MIX);
        k_attn<<<BATCH * NCH * NQH, 128, 0, stream>>>(P, in[14], in[15], in[16], MIX);
    }
    a.ph_lo = 6; a.ph_hi = 10; a.li = 1;
    hipLaunchKernelGGL(mega_fwd, dim3(grid), dim3(NWAVES * 64), LDS_BYTES, stream, a);
#endif
}
```

```cpp
#include <hip/hip_runtime.h>
#include <cstdio>
#include <cstdint>
#include <cstring>
#ifndef N_LAUNCHES
#define N_LAUNCHES 1
#endif

typedef unsigned short bf16_t;
typedef short bf16x8 __attribute__((ext_vector_type(8)));
typedef float f32x4 __attribute__((ext_vector_type(4)));
typedef float f32x2 __attribute__((ext_vector_type(2)));
typedef unsigned u32x4 __attribute__((ext_vector_type(4)));
typedef unsigned u32x2 __attribute__((ext_vector_type(2)));
#define GAS __attribute__((address_space(1)))
#define LAS __attribute__((address_space(3)))
#define RLX_AGENT __ATOMIC_RELAXED, __HIP_MEMORY_SCOPE_AGENT
#define LDS_WAIT() asm volatile("s_waitcnt lgkmcnt(0)" ::: "memory")
#define VM_WAIT() asm volatile("s_waitcnt vmcnt(0)" ::: "memory")

__device__ __forceinline__ float bf2f(bf16_t h) { return __uint_as_float(((unsigned)h) << 16); }
__device__ __forceinline__ unsigned f2bf(float f) { unsigned u = __float_as_uint(f); return (u + 0x7fffu + ((u >> 16) & 1u)) >> 16; }
__device__ __forceinline__ unsigned pk2(float lo, float hi) { return f2bf(lo) | (f2bf(hi) << 16); }
__device__ __forceinline__ unsigned cvt_pk_bf16(float lo, float hi) { unsigned r; asm volatile("v_cvt_pk_bf16_f32 %0, %1, %2" : "=v"(r) : "v"(lo), "v"(hi)); return r; }
__device__ __forceinline__ float bflo(unsigned w) { return __uint_as_float(w << 16); }
__device__ __forceinline__ float bfhi(unsigned w) { return __uint_as_float(w & 0xffff0000u); }

constexpr int BATCH = 16, SEQ = 2048, D = 1024, M = BATCH * SEQ;
constexpr int FF = 2816, NGU = 2 * FF;
constexpr int DA = 512, DB = 512, NIN = 3840, NMOD = 9 * D;
constexpr int CHUNK = 128, NCH = SEQ / CHUNK, NG = 4, GD = 128;
constexpr int HD = 64, NQH = 8, NKVH = 2;
constexpr int PC_U = 0, PC_V = 512, PC_Q = 1024, PC_K = 1536, PC_VV = 1664, PC_GA = 1792, PC_GB = 2816;
constexpr float EPS = 1e-6f;
constexpr float LOG2E = 1.4426950408889634f;

constexpr size_t MiB = 1u << 20;
constexpr size_t WS_CTL = 0, CTL_BYTES = 64 * 1024;
constexpr int CW_BAR = 4096;
constexpr size_t WS_MODS = 1 * MiB;
constexpr size_t WS_CB1 = WS_MODS + 640 * 1024;
constexpr size_t WS_CB2 = WS_CB1 + 352 * 1024;
constexpr size_t WS_CB3 = WS_CB2 + 240 * 1024;
constexpr size_t WS_SS1 = WS_CB3 + 352 * 1024;
constexpr size_t WS_SS2 = WS_SS1 + 512 * 1024, WS_SS3 = WS_SS2 + 512 * 1024;
constexpr size_t WS_SMALL_END = WS_SS3 + 512 * 1024;
static_assert(WS_SMALL_END <= 5 * MiB, "small tables");
constexpr size_t WS_WGU1 = 5 * MiB;
constexpr size_t WS_WD1 = WS_WGU1 + (size_t)NGU * D * 2;
constexpr size_t WS_WIN = WS_WD1 + (size_t)D * FF * 2;
constexpr size_t WS_WA = WS_WIN + (size_t)NIN * D * 2;
constexpr size_t WS_WB = WS_WA + (size_t)D * DA * 2;
constexpr size_t WS_WO = WS_WB + (size_t)D * DB * 2;
constexpr size_t WS_WGU2 = WS_WO + (size_t)D * D * 2;
constexpr size_t WS_WD2 = WS_WGU2 + (size_t)NGU * D * 2;
constexpr size_t WS_WSP = WS_WD2 + (size_t)D * FF * 2;
constexpr size_t WS_W_END = WS_WSP + (size_t)NG * CHUNK * CHUNK * 2;
static_assert(WS_W_END <= 50 * MiB, "weights");
constexpr size_t WS_XN = 50 * MiB;
constexpr size_t WS_MIX = 50 * MiB;
constexpr size_t WS_H16 = 114 * MiB;
constexpr size_t WS_MERGED = 178 * MiB;
constexpr size_t WS_ACT = 242 * MiB;
constexpr size_t WS_P = 242 * MiB;
constexpr size_t WS_END = 482 * MiB;

#ifdef PROBE_STAMPS
#define STAMP(id) do { if (blockIdx.x == 0 && threadIdx.x == 0) ((unsigned long long*)(g_ws_ + WS_CTL))[40 + (id)] = __builtin_amdgcn_s_memrealtime(); } while (0)
#else
#define STAMP(id) do {} while (0)
#endif
__device__ __forceinline__ float fsigmoid(float v) { return __builtin_amdgcn_rcpf(1.0f + __builtin_amdgcn_exp2f(-LOG2E * v)); }
__device__ __forceinline__ float fgelu_tanh(float v) {
    const float u = 0.7978845608028654f * (v + 0.044715f * v * v * v);
    return v * fsigmoid(2.0f * u);
}

namespace pg8 {
constexpr int BM = 256, BK = 64, HALF = 128, HTB = HALF * BK * 2  , STAGE_BYTES = 8 * HTB, NXCD = 8, WGM = 8;

__host__ __device__ __forceinline__ int lds_byte(int r, int c) { const int st = (r >> 4) * 2 + (c >> 5), rr = r & 15, cc = c & 31, ob = rr * 64 + cc * 2; return st * 1024 + (ob ^ (((ob >> 9) & 1) << 5)); }
__host__ __device__ __forceinline__ void stage_rc(int b, int& R, int& C) { const int st = b / 1024, sb = b % 1024, swz = sb ^ (((sb >> 9) & 1) << 5); R = (st >> 1) * 16 + swz / 64; C = (st & 1) * 32 + (swz % 64) / 2; }
__host__ __device__ __forceinline__ int perm32(int rho) { const int n = rho >> 4, i = rho & 15; return 8 * (i >> 2) + 4 * n + (i & 3); }

struct Unit { int pm, pn, seg; };
struct Gemm { const bf16_t* A0; const bf16_t* A1; const bf16_t* B0; const bf16_t* B1; int lda, ldb, K; };

struct StaticOrder {
    int nM, nN, nwg, G, c, nseg;
    __host__ __device__ void init(int M_, int N_, int G_, int c_, int nseg_ = 1) { nM = M_ / BM; nN = N_ / BM; nwg = nM * nN; G = G_; c = c_; nseg = nseg_; }
    __host__ __device__ bool next(int i, Unit& u) const {
        const int ti = (nseg == 1) ? i : (i >> 1);
        const long L = (long)ti * G + c; if (L >= nwg) return false;
        int wgid = (int)L; { const int q = nwg / NXCD, r = nwg % NXCD, xcd = wgid % NXCD, off = wgid / NXCD; wgid = (xcd < r ? xcd * (q + 1) : r * (q + 1) + (xcd - r) * q) + off; }
        const int nig = WGM * nN, gid = wgid / nig, fm = gid * WGM, gsz = (nM - fm) < WGM ? (nM - fm) : WGM;
        u.pm = fm + ((wgid % nig) % gsz); u.pn = (wgid % nig) / gsz; u.seg = (nseg == 1) ? 0 : (i & 1); return true;
    }
};

template <class Epi, class Sched>
__device__ __forceinline__ void gemm_phase(LAS unsigned char* lds, const Gemm g, const Sched& S, const Epi& E, unsigned long long& epi_ticks) {
    const int tid = threadIdx.x, wid = __builtin_amdgcn_readfirstlane(tid >> 6), lane = tid & 63, wr = wid >> 2, wc = wid & 3, fr = lane & 15, fq = lane >> 4;
    const int nt = g.K / BK;
    unsigned voffA[2], voffB[2];
#pragma unroll
    for (int i = 0; i < 2; ++i) { int R, C; stage_rc(tid * 16 + i * 8192, R, C); const int Rb = Epi::MAPB ? ((R >> 5) * 64 + perm32(R & 31)) : ((R & ~31) + perm32(R & 31));
        voffA[i] = (unsigned)(R * g.lda + C) * 2u; voffB[i] = (unsigned)(Rb * g.ldb + C) * 2u; }
    const size_t kstep = (size_t)(BK * 2);
    const size_t hstepA = (size_t)HALF * g.lda * 2, hstepB = (size_t)HALF * g.ldb * 2;
    const size_t tstepA = 2 * hstepA, tstepB = 2 * hstepB;
    const size_t hoffB = Epi::MAPB ? (size_t)32 * g.ldb * 2 : hstepB;
    const unsigned ldsw = (unsigned)wid * 1024u;
    const int aoff = lds_byte(wr * 64 + fr, fq * 8), boff = lds_byte(wc * 32 + fr, fq * 8);
#define PG8_SA(b, h) (((b) * 2 + (h)) * HTB)
#define PG8_SB(b, h) ((4 + (b) * 2 + (h)) * HTB)
#define PG8_STAGE(bufoff, gbase, voff) do { _Pragma("unroll") for (int _i = 0; _i < 2; ++_i) \
        __builtin_amdgcn_global_load_lds((const unsigned*)((const char*)(gbase) + (voff)[_i]), (LAS unsigned*)(lds + (bufoff) + ldsw + _i * 8192), 16, 0, 0); } while (0)
#define PG8_LDA(dst, b, h) do { _Pragma("unroll") for (int m = 0; m < 4; ++m) _Pragma("unroll") for (int k = 0; k < 2; ++k) dst[m][k] = *(const LAS bf16x8*)(lds + PG8_SA(b, h) + aoff + m * 2048 + k * 1024); } while (0)
#define PG8_LDB(dst, b, h) do { _Pragma("unroll") for (int n = 0; n < 2; ++n) _Pragma("unroll") for (int k = 0; k < 2; ++k) dst[n][k] = *(const LAS bf16x8*)(lds + PG8_SB(b, h) + boff + n * 2048 + k * 1024); } while (0)
#define PG8_MMA(ai, bj, At, Bt) do { __builtin_amdgcn_s_setprio(1); _Pragma("unroll") for (int m = 0; m < 4; ++m) _Pragma("unroll") for (int n = 0; n < 2; ++n) _Pragma("unroll") for (int k = 0; k < 2; ++k) \
        acc[ai][bj][m][n] = __builtin_amdgcn_mfma_f32_16x16x32_bf16(Bt[n][k], At[m][k], acc[ai][bj][m][n], 0, 0, 0); __builtin_amdgcn_s_setprio(0); } while (0)
#define PG8_WAIT_V(n) asm volatile("s_waitcnt vmcnt(" #n ")" ::: "memory")
#define PG8_WAIT_L(n) asm volatile("s_waitcnt lgkmcnt(" #n ")" ::: "memory")
#define PG8_BAR __builtin_amdgcn_s_barrier()
#define PG8_SCHED __builtin_amdgcn_sched_barrier(0)
    Unit cur, nxt; int ui = 0;
    if (!S.next(0, cur)) return;
    f32x4 acc[2][2][4][2];
#pragma unroll
    for (int a = 0; a < 2; ++a)
#pragma unroll
        for (int b = 0; b < 2; ++b)
#pragma unroll
            for (int m = 0; m < 4; ++m)
#pragma unroll
                for (int n = 0; n < 2; ++n) acc[a][b][m][n] = (f32x4){0.f, 0.f, 0.f, 0.f};
    bf16x8 At[4][2], B0[2][2], B1[2][2];
    const char* cA = (const char*)(cur.seg ? g.A1 : g.A0) + (size_t)cur.pm * tstepA; const char* cB = (const char*)(cur.seg ? g.B1 : g.B0) + (size_t)cur.pn * tstepB;
    PG8_STAGE(PG8_SB(0, 0), cB, voffB); PG8_STAGE(PG8_SB(0, 1), cB + hoffB, voffB); PG8_STAGE(PG8_SA(0, 0), cA, voffA); PG8_STAGE(PG8_SA(0, 1), cA + hstepA, voffA);
    if (wr == 1) PG8_BAR;
    PG8_WAIT_V(2); PG8_BAR;
    PG8_STAGE(PG8_SB(1, 0), cB + kstep, voffB); PG8_STAGE(PG8_SA(1, 0), cA + kstep, voffA); PG8_STAGE(PG8_SB(1, 1), cB + hoffB + kstep, voffB);
    PG8_WAIT_V(6); PG8_BAR;
    for (;;) {
        const bool has_next = S.next(ui + 1, nxt);
        const char* nA = has_next ? (const char*)(nxt.seg ? g.A1 : g.A0) + (size_t)nxt.pm * tstepA : cA; const char* nB = has_next ? (const char*)(nxt.seg ? g.B1 : g.B0) + (size_t)nxt.pn * tstepB : cB;
#ifdef PROBE_KLOOP
        const unsigned long long tk0_ = __builtin_amdgcn_s_memrealtime();
#endif
        for (int t = 0; t < nt; t += 2) {
            const bool last = (t == nt - 2);
            const char* a1 = cA + (size_t)(t + 1) * kstep;
            const char* a2 = last ? nA : cA + (size_t)(t + 2) * kstep; const char* b2 = last ? nB : cB + (size_t)(t + 2) * kstep;
            const char* a3 = a2 + kstep; const char* b3 = b2 + kstep;
            PG8_LDB(B0, 0, 0); PG8_LDB(B1, 0, 1); PG8_SCHED; PG8_LDA(At, 0, 0); PG8_STAGE(PG8_SA(1, 1), a1 + hstepA, voffA);
            PG8_WAIT_V(8); PG8_WAIT_L(0); PG8_BAR; PG8_MMA(0, 0, At, B0); PG8_MMA(0, 1, At, B1); PG8_BAR; PG8_SCHED;
            PG8_LDA(At, 0, 1); PG8_STAGE(PG8_SB(0, 0), b2, voffB); PG8_STAGE(PG8_SB(0, 1), b2 + hoffB, voffB); PG8_STAGE(PG8_SA(0, 0), a2, voffA);
            PG8_WAIT_V(8); PG8_WAIT_L(0); PG8_BAR; PG8_MMA(1, 0, At, B0); PG8_MMA(1, 1, At, B1); PG8_BAR; PG8_SCHED;
            PG8_LDB(B0, 1, 0); PG8_LDB(B1, 1, 1); PG8_SCHED; PG8_LDA(At, 1, 0); PG8_STAGE(PG8_SA(0, 1), a2 + hstepA, voffA);
            PG8_WAIT_V(8); PG8_WAIT_L(0); PG8_BAR; PG8_MMA(0, 0, At, B0); PG8_MMA(0, 1, At, B1); PG8_BAR; PG8_SCHED;
            PG8_LDA(At, 1, 1); PG8_STAGE(PG8_SB(1, 0), b3, voffB); PG8_STAGE(PG8_SB(1, 1), b3 + hoffB, voffB); PG8_STAGE(PG8_SA(1, 0), a3, voffA);
            PG8_WAIT_V(8); PG8_WAIT_L(0); PG8_BAR; PG8_MMA(1, 0, At, B0); PG8_MMA(1, 1, At, B1); PG8_BAR; PG8_SCHED;
        }
#ifdef PROBE_KLOOP
        epi_ticks += __builtin_amdgcn_s_memrealtime() - tk0_;
#endif
        if (wr == 0) PG8_BAR;
#ifdef PROBE_LO
        const unsigned long long te0_ = __builtin_amdgcn_s_memrealtime();
#endif
        const bool keep = E(acc, cur, wr, wc, fr, fq);
#if defined(PROBE_LO) && !defined(PROBE_KLOOP)
        asm volatile("s_waitcnt vmcnt(0)" ::: "memory"); epi_ticks += __builtin_amdgcn_s_memrealtime() - te0_;
#endif
        if (!has_next) break;
        if (!keep) {
#pragma unroll
            for (int a = 0; a < 2; ++a)
#pragma unroll
                for (int b = 0; b < 2; ++b)
#pragma unroll
                    for (int m = 0; m < 4; ++m)
#pragma unroll
                        for (int n = 0; n < 2; ++n) acc[a][b][m][n] = (f32x4){0.f, 0.f, 0.f, 0.f};
        }
        cur = nxt; cA = nA; cB = nB; ++ui;
        if (wr == 1) PG8_BAR;
    }
    PG8_WAIT_V(0);
    PG8_BAR;
#undef PG8_SA
#undef PG8_SB
#undef PG8_STAGE
#undef PG8_LDA
#undef PG8_LDB
#undef PG8_MMA
#undef PG8_WAIT_V
#undef PG8_WAIT_L
#undef PG8_BAR
#undef PG8_SCHED
}
}

using pg8::Unit;
template <bool MAPB> __device__ __forceinline__ int colbase(const Unit& u, int bj, int wc, int fq) { return MAPB ? (u.pn * 256 + wc * 64 + bj * 32 + 8 * fq) : (u.pn * 256 + bj * 128 + wc * 32 + 8 * fq); }
__device__ __forceinline__ float rstd_of(const float* ss, int m) { const f32x4 p = *(const f32x4*)(ss + 4 * (size_t)m); return __builtin_amdgcn_rsqf(((p[0] + p[1]) + (p[2] + p[3])) * (1.0f / D) + EPS); }

template <bool RAW  > struct EpiGU {
    static constexpr bool MAPB = false;
    bf16_t* act; const float* ss; const float* cb;
    __device__ __forceinline__ bool operator()(f32x4 (&acc)[2][2][4][2], const Unit& u, int wr, int wc, int fr, int fq) const {
        const int b = u.pm >> 3;
        const float* cbp = cb + b * NGU + u.pn * 256 + wc * 32 + 8 * fq;
        f32x4 cg[2], cu[2];
        if constexpr (!RAW) {
#pragma unroll
            for (int n = 0; n < 2; ++n) { cg[n] = *(const f32x4*)(cbp + 4 * n); cu[n] = *(const f32x4*)(cbp + 128 + 4 * n); } }
#pragma unroll
        for (int ai = 0; ai < 2; ++ai)
#pragma unroll
            for (int m = 0; m < 4; ++m) {
                const int row = u.pm * 256 + ai * 128 + wr * 64 + m * 16 + fr; float rs = 1.0f; if constexpr (!RAW) rs = rstd_of(ss, row);
                unsigned w[4];
#pragma unroll
                for (int n = 0; n < 2; ++n) { f32x4 gv = acc[ai][0][m][n], uv = acc[ai][1][m][n]; if constexpr (!RAW) { gv = gv * rs + cg[n]; uv = uv * rs + cu[n]; } float o[4];
#pragma unroll
                    for (int i = 0; i < 4; ++i) o[i] = gv[i] * uv[i] * fsigmoid(gv[i]);
                    w[2 * n] = cvt_pk_bf16(o[0], o[1]); w[2 * n + 1] = cvt_pk_bf16(o[2], o[3]); }
                __builtin_nontemporal_store((u32x4){w[0], w[1], w[2], w[3]}, (u32x4*)(act + (size_t)row * FF + u.pn * 128 + wc * 32 + 8 * fq));
            }
        return false;
    }
};
typedef _Float16 f16x2 __attribute__((ext_vector_type(2)));
__device__ __forceinline__ unsigned pk_f16(float lo, float hi) { const f16x2 h = {(_Float16)lo, (_Float16)hi}; return __builtin_bit_cast(unsigned, h); }
__device__ __forceinline__ f32x2 unpk_f16(unsigned w) { const f16x2 h = __builtin_bit_cast(f16x2, w); return (f32x2){(float)h[0], (float)h[1]}; }
template <bool NORM, bool RIN16, bool ROUT16> struct EpiRes {
    static constexpr bool MAPB = true;
    const void* resid; void* hout; const float* ga; const float* gn; const float* sc; bf16_t* xn; float* ssq; LAS float* red; float gscale;
    __device__ __forceinline__ bool operator()(f32x4 (&acc)[2][2][4][2], const Unit& u, int wr, int wc, int fr, int fq) const {
        const int b = u.pm >> 3;
        f32x4 gav[2][2], gsv[2][2];
#pragma unroll
        for (int bj = 0; bj < 2; ++bj)
#pragma unroll
            for (int n = 0; n < 2; ++n) { const int c = colbase<MAPB>(u, bj, wc, fq) + 4 * n;
                gav[bj][n] = *(const f32x4*)(ga + b * NMOD + c) * gscale;
                if constexpr (NORM) gsv[bj][n] = *(const f32x4*)(gn + c) * (*(const f32x4*)(sc + b * NMOD + c) + 1.0f); }
#pragma unroll
        for (int ai = 0; ai < 2; ++ai)
#pragma unroll
            for (int m = 0; m < 4; ++m) {
                const int row = u.pm * 256 + ai * 128 + wr * 64 + m * 16 + fr; float s = 0.f;
#pragma unroll
                for (int bj = 0; bj < 2; ++bj) { const size_t off = (size_t)row * D + colbase<MAPB>(u, bj, wc, fq);
                    f32x4 r0, r1;
                    if constexpr (RIN16) { const u32x4 rw = *(const u32x4*)((const _Float16*)resid + off); const f32x2 q0 = unpk_f16(rw[0]), q1 = unpk_f16(rw[1]), q2 = unpk_f16(rw[2]), q3 = unpk_f16(rw[3]); r0 = (f32x4){q0[0], q0[1], q1[0], q1[1]}; r1 = (f32x4){q2[0], q2[1], q3[0], q3[1]}; }
                    else { r0 = *(const f32x4*)((const float*)resid + off); r1 = *(const f32x4*)((const float*)resid + off + 4); }
                    const f32x4 v0 = r0 + gav[bj][0] * acc[ai][bj][m][0], v1 = r1 + gav[bj][1] * acc[ai][bj][m][1];
                    if constexpr (ROUT16) *(u32x4*)((_Float16*)hout + off) = (u32x4){pk_f16(v0[0], v0[1]), pk_f16(v0[2], v0[3]), pk_f16(v1[0], v1[1]), pk_f16(v1[2], v1[3])};
                    else { __builtin_nontemporal_store(v0, (f32x4*)((float*)hout + off)); __builtin_nontemporal_store(v1, (f32x4*)((float*)hout + off + 4)); }
                    if constexpr (NORM) { const f32x4 a0 = v0 * gsv[bj][0], a1 = v1 * gsv[bj][1];
                        *(u32x4*)(xn + off) = (u32x4){cvt_pk_bf16(a0[0], a0[1]), cvt_pk_bf16(a0[2], a0[3]), cvt_pk_bf16(a1[0], a1[1]), cvt_pk_bf16(a1[2], a1[3])};
                        s += (v0[0] * v0[0] + v0[1] * v0[1]) + (v0[2] * v0[2] + v0[3] * v0[3]) + (v1[0] * v1[0] + v1[1] * v1[1]) + (v1[2] * v1[2] + v1[3] * v1[3]); } }
                if constexpr (NORM) { s += __shfl_xor(s, 16); s += __shfl_xor(s, 32); if (fq == 0) red[(ai * 128 + wr * 64 + m * 16 + fr) * 4 + wc] = s; }
                if (m == 3) asm volatile("" ::: "memory");
            }
        if constexpr (NORM) {
            asm volatile("s_waitcnt lgkmcnt(0)" ::: "memory"); __builtin_amdgcn_s_barrier(); asm volatile("" ::: "memory");
            const int tid = threadIdx.x;
            if (tid < 256) { const f32x4 p = *(const LAS f32x4*)(red + 4 * tid); ssq[(size_t)(u.pm * 256 + tid) * 4 + u.pn] = (p[0] + p[1]) + (p[2] + p[3]); }
        }
        return false;
    }
};
struct EpiWin {
    static constexpr bool MAPB = true;
    bf16_t* P; const float* ss; const float* cb;
    __device__ __forceinline__ bool operator()(f32x4 (&acc)[2][2][4][2], const Unit& u, int wr, int wc, int fr, int fq) const {
        const int b = u.pm >> 3; const int kind = u.pn < 4 ? 0 : (u.pn < 7 ? 1 : 2);
        f32x4 cv[2][2];
#pragma unroll
        for (int bj = 0; bj < 2; ++bj)
#pragma unroll
            for (int n = 0; n < 2; ++n) cv[bj][n] = *(const f32x4*)(cb + b * NIN + colbase<MAPB>(u, bj, wc, fq) + 4 * n);
#pragma unroll
        for (int ai = 0; ai < 2; ++ai)
#pragma unroll
            for (int m = 0; m < 4; ++m) {
                const int row = u.pm * 256 + ai * 128 + wr * 64 + m * 16 + fr; const float rs = rstd_of(ss, row);
#pragma unroll
                for (int bj = 0; bj < 2; ++bj) { unsigned w[4];
#pragma unroll
                    for (int n = 0; n < 2; ++n) { f32x4 v = acc[ai][bj][m][n] * rs + cv[bj][n];
                        if (kind == 0) { v[0] = fgelu_tanh(v[0]); v[1] = fgelu_tanh(v[1]); v[2] = fgelu_tanh(v[2]); v[3] = fgelu_tanh(v[3]); }
                        else if (kind == 2) { v[0] = fsigmoid(v[0]); v[1] = fsigmoid(v[1]); v[2] = fsigmoid(v[2]); v[3] = fsigmoid(v[3]); }
                        w[2 * n] = cvt_pk_bf16(v[0], v[1]); w[2 * n + 1] = cvt_pk_bf16(v[2], v[3]); }
                    __builtin_nontemporal_store((u32x4){w[0], w[1], w[2], w[3]}, (u32x4*)(P + (size_t)row * NIN + colbase<MAPB>(u, bj, wc, fq))); }
            }
        return false;
    }
};
struct EpiBranch {
    static constexpr bool MAPB = true;
    const bf16_t* P; bf16_t* merged;
    __device__ __forceinline__ bool operator()(f32x4 (&acc)[2][2][4][2], const Unit& u, int wr, int wc, int fr, int fq) const {
#pragma unroll
        for (int ai = 0; ai < 2; ++ai)
#pragma unroll
            for (int m = 0; m < 4; ++m) {
                const int row = u.pm * 256 + ai * 128 + wr * 64 + m * 16 + fr;
#pragma unroll
                for (int bj = 0; bj < 2; ++bj) { const int c = colbase<MAPB>(u, bj, wc, fq);
                    const u32x4 gb = *(const u32x4*)(P + (size_t)row * NIN + PC_GB + c);
                    float sb[8] = {bflo(gb[0]), bfhi(gb[0]), bflo(gb[1]), bfhi(gb[1]), bflo(gb[2]), bfhi(gb[2]), bflo(gb[3]), bfhi(gb[3])};
                    if (u.seg == 0) {
                        const u32x4 gaw = *(const u32x4*)(P + (size_t)row * NIN + PC_GA + c);
                        const float sa[8] = {bflo(gaw[0]), bfhi(gaw[0]), bflo(gaw[1]), bfhi(gaw[1]), bflo(gaw[2]), bfhi(gaw[2]), bflo(gaw[3]), bfhi(gaw[3])};
#pragma unroll
                        for (int i = 0; i < 4; ++i) { acc[ai][bj][m][0][i] *= sa[i] * __builtin_amdgcn_rcpf(fmaxf(sb[i], 1e-30f)); acc[ai][bj][m][1][i] *= sa[4 + i] * __builtin_amdgcn_rcpf(fmaxf(sb[4 + i], 1e-30f)); }
                    } else {
                        const f32x4 a0 = acc[ai][bj][m][0], a1 = acc[ai][bj][m][1];
                        *(u32x4*)(merged + (size_t)row * D + c) = (u32x4){cvt_pk_bf16(a0[0] * sb[0], a0[1] * sb[1]), cvt_pk_bf16(a0[2] * sb[2], a0[3] * sb[3]), cvt_pk_bf16(a1[0] * sb[4], a1[1] * sb[5]), cvt_pk_bf16(a1[2] * sb[6], a1[3] * sb[7])};
                    } }
                if (m == 3) asm volatile("" ::: "memory");
            }
        return u.seg == 0;
    }
};

#define XB_TMO      128
#define XB_XCNT(j)  (256  + 64 * (j))
#define XB_XSUB(j)  (1280 + 64 * (j))
#define XB_XGEN(j)  (2304 + 64 * (j))
#define XB_TOP      3328
#define XB_TOPGEN   3392
#define XCD_BAR_WORDS 3456
#define XB_SPIN_CAP (1u << 18)

__device__ __forceinline__ unsigned xb_ld(unsigned* p)              { return __hip_atomic_load(p, __ATOMIC_RELAXED, __HIP_MEMORY_SCOPE_AGENT); }
__device__ __forceinline__ unsigned xb_add(unsigned* p, unsigned v) { return __hip_atomic_fetch_add(p, v, __ATOMIC_RELAXED, __HIP_MEMORY_SCOPE_AGENT); }
__device__ __forceinline__ unsigned xb_xcc_id() { return (unsigned)__builtin_amdgcn_s_getreg((3 << 11) | 20) & 0xFu; }
#define XB_SPIN(cond, bar) do { unsigned _sp = 0; while (cond) { __builtin_amdgcn_s_sleep(1); \
    if ((++_sp & 255u) == 0u) { if (xb_ld(&(bar)[XB_TMO])) break; if (_sp > XB_SPIN_CAP) { atomicAdd(&(bar)[XB_TMO], 1u); break; } } } } while (0)

struct XcdBarrier {
    unsigned* bar; unsigned x;
    volatile LAS unsigned* st;
};

__device__ __forceinline__ XcdBarrier xcd_barrier_post(unsigned* bar, volatile LAS unsigned* st) {
    XcdBarrier b; b.bar = bar; b.x = xb_xcc_id(); b.st = st;
    if (threadIdx.x == 0) (void)xb_add(&bar[XB_XCNT(b.x)], 1u);
    return b;
}
__device__ __forceinline__ void xcd_barrier_complete(unsigned* bar, unsigned x, unsigned& nloc, unsigned& nx) {
    const unsigned G = gridDim.x * gridDim.y * gridDim.z;
    unsigned sum, cnt, mine, sp = 0u;
    for (;;) {
        sum = 0u; cnt = 0u; mine = 0u;
#pragma unroll
        for (unsigned j = 0; j < 16; ++j) { const unsigned c = xb_ld(&bar[XB_XCNT(j)]); sum += c; cnt += (c > 0u) ? 1u : 0u; mine = (j == x) ? c : mine; }
        if (sum == G) break;
        __builtin_amdgcn_s_sleep(1);
        if ((++sp & 255u) == 0u) { if (xb_ld(&bar[XB_TMO])) break; if (sp > XB_SPIN_CAP) { atomicAdd(&bar[XB_TMO], 1u); break; } }
    }
    nloc = mine > 0u ? mine : 1u; nx = cnt > 0u ? cnt : 1u;
}

__device__ __forceinline__ void xcd_barrier(const XcdBarrier& b) {
    asm volatile("s_waitcnt vmcnt(0)" ::: "memory");
    __syncthreads();
    if (threadIdx.x == 0) {
        unsigned* bar = b.bar;
        __builtin_amdgcn_s_waitcnt(0);
        unsigned nloc = b.st[0], nx = b.st[1];
        if (nloc == 0u) { xcd_barrier_complete(bar, b.x, nloc, nx); b.st[0] = nloc; b.st[1] = nx; }
        const unsigned old = xb_add(&bar[XB_XSUB(b.x)], 1u);
        const unsigned gen = old / nloc;
        if (old + 1u == (gen + 1u) * nloc) {
            __builtin_amdgcn_fence(__ATOMIC_RELEASE, "agent");
            asm volatile("s_waitcnt vmcnt(0)" ::: "memory");
            const unsigned og = xb_add(&bar[XB_TOP], 1u);
            const unsigned tg = og / nx;
            if (og + 1u == (tg + 1u) * nx) xb_add(&bar[XB_TOPGEN], 1u);
            else XB_SPIN(xb_ld(&bar[XB_TOPGEN]) == tg, bar);
            __builtin_amdgcn_fence(__ATOMIC_ACQUIRE, "agent");
            xb_add(&bar[XB_XGEN(b.x)], 1u);
            asm volatile("s_waitcnt vmcnt(0)" ::: "memory");
        } else {
            XB_SPIN(xb_ld(&bar[XB_XGEN(b.x)]) == gen, bar);
            __builtin_amdgcn_fence(__ATOMIC_ACQUIRE, "agent");
            asm volatile("s_waitcnt vmcnt(0)" ::: "memory");
        }
    }
    __syncthreads();
}

constexpr int NWAVES = 8;
constexpr int RING_OFF = 0, RING_BYTES = 131072;
constexpr int LDSCTL_OFF = RING_BYTES, MISC_OFF = LDSCTL_OFF + 320, RED_OFF = LDSCTL_OFF + 4096;
constexpr int LDS_BYTES = 147456;
static_assert(MISC_OFF + 128 <= RED_OFF && RED_OFF + 4096 <= LDS_BYTES, "LDS map");

struct Frame {
    LAS unsigned char* lds;
    volatile LAS unsigned* MISC;
    int tid, lane, wave;
    int vcu, G;
};
struct Args { const float* in[24]; float* out; unsigned char* ws; int ph_lo, ph_hi, li, pad; };

__device__ __forceinline__ float wave_sum(float v) {
#pragma unroll
    for (int o = 1; o < 64; o <<= 1) v += __shfl_xor(v, o);
    return v;
}
__device__ __forceinline__ void p0_mods_item(const Frame& F, const float* c, const float* w_ada, const float* b_ada, float* mods, int item, bool fill) {
    LAS float* sc = (LAS float*)(F.lds + RING_OFF);
    LAS float* red = (LAS float*)(F.lds + RING_OFF + 65536);
    if (fill) { for (int i = F.tid; i < BATCH * D; i += NWAVES * 64) { const float v = c[i]; sc[i] = v * fsigmoid(v); } __syncthreads(); }
    const int j = item * 64 + F.lane, k0 = F.wave * 128;
    float acc[BATCH];
#pragma unroll
    for (int b = 0; b < BATCH; ++b) acc[b] = 0.f;
#pragma unroll 2
    for (int kb = 0; kb < 128; kb += 16) {
        float wv[16];
#pragma unroll
        for (int i = 0; i < 16; ++i) wv[i] = w_ada[(size_t)(k0 + kb + i) * NMOD + j];
#pragma unroll
        for (int q = 0; q < 4; ++q)
#pragma unroll
            for (int b = 0; b < BATCH; ++b) { const f32x4 s4 = *(const LAS f32x4*)(sc + b * D + k0 + kb + 4 * q);
                acc[b] += s4[0] * wv[4 * q] + s4[1] * wv[4 * q + 1] + s4[2] * wv[4 * q + 2] + s4[3] * wv[4 * q + 3]; }
    }
#pragma unroll
    for (int b = 0; b < BATCH; ++b) red[(F.wave * BATCH + b) * 64 + F.lane] = acc[b];
    __syncthreads();
    for (int i = F.tid; i < BATCH * 64; i += NWAVES * 64) { const int b = i >> 6, l = i & 63; float s = 0.f;
#pragma unroll
        for (int w = 0; w < NWAVES; ++w) s += red[(w * BATCH + b) * 64 + l];
        mods[b * NMOD + item * 64 + l] = s + b_ada[item * 64 + l]; }
    __syncthreads();
}
__device__ __forceinline__ void p0_transpose_item(const float* W, int K, int N, bf16_t* WT, int gu, LAS float* scr, int item, int lane) {
    const int nblk = N / 32, kb = item / nblk, nb = item % nblk, k0 = 64 * kb, n0 = 32 * nb;
    {
        const int kk = lane >> 3, nq = lane & 7; f32x4 v[8];
#pragma unroll
        for (int i = 0; i < 8; ++i) v[i] = *(const f32x4*)(W + (size_t)(k0 + 8 * i + kk) * N + n0 + 4 * nq);
#pragma unroll
        for (int i = 0; i < 8; ++i) { LAS float* d = scr + (8 * i + kk) * 33 + 4 * nq; d[0] = v[i][0]; d[1] = v[i][1]; d[2] = v[i][2]; d[3] = v[i][3]; }
    }
    LDS_WAIT(); asm volatile("" ::: "memory");
    const int c = lane & 7;
    const int r0 = gu ? (256 * (n0 >> 7) + (n0 & 127) + 128 * (gu - 1)) : n0;
#pragma unroll
    for (int j = 0; j < 4; ++j) { const int n = (lane >> 3) + 8 * j; const LAS float* s = scr + (8 * c) * 33 + n;
        u32x4 o; o.x = pk2(s[0 * 33], s[1 * 33]); o.y = pk2(s[2 * 33], s[3 * 33]); o.z = pk2(s[4 * 33], s[5 * 33]); o.w = pk2(s[6 * 33], s[7 * 33]);
        *(GAS u32x4*)(WT + (size_t)(r0 + n) * K + k0 + 8 * c) = o; }
    LDS_WAIT(); asm volatile("" ::: "memory");
}
struct WsPtrs {
    float *mods, *cb1, *cb2, *cb3, *ss1, *ss2, *ss3;
    bf16_t *WGU1, *WD1, *WIN, *WA, *WB, *WO, *WGU2, *WD2, *WSP, *XN, *MIX, *MERGED, *ACT, *P; _Float16* H16;
};
__device__ __forceinline__ void late_conversions(const Frame& F, const Args& a, const WsPtrs& w, int widx, int NW) {
    LAS float* scr = (LAS float*)(F.lds + RING_OFF + F.wave * 16384);
    constexpr int I_G = (D / 64) * (FF / 32), I_D = (FF / 64) * (D / 32);
    for (int it = widx; it < 2 * I_G + I_D; it += NW) {
        int r = it;
        if (r < I_G) { p0_transpose_item(a.in[21], D, FF, w.WGU2, 1, scr, r, F.lane); continue; } r -= I_G;
        if (r < I_G) { p0_transpose_item(a.in[22], D, FF, w.WGU2, 2, scr, r, F.lane); continue; } r -= I_G;
        p0_transpose_item(a.in[23], FF, D, w.WD2, 0, scr, r, F.lane);
    }
}
__device__ __forceinline__ void xpass(const Frame& F, const Args& a, const WsPtrs& w);
constexpr int CW_MODS_DONE = 128;
__device__ __forceinline__ void p0_prologue(const Frame& F, const Args& a, const WsPtrs& w) {
    if (F.vcu < NMOD / 64) p0_mods_item(F, a.in[1], a.in[2], a.in[3], w.mods, F.vcu, true);
    LAS float* scr = (LAS float*)(F.lds + RING_OFF + F.wave * 16384);
    const int gw = F.vcu * NWAVES + F.wave, NGW = F.G * NWAVES;
    constexpr int I_G = (D / 64) * (FF / 32), I_D = (FF / 64) * (D / 32), I_IN = (D / 64) * (NIN / 32), I_AB = (DA / 64) * (D / 32), I_O = (D / 64) * (D / 32);
    constexpr int NITEMS = 4 * I_G + 2 * I_D + I_IN + 2 * I_AB + I_O;
    constexpr int NMODCU = NMOD / 64, R0 = 4;
    const bool balanced = (F.G == 256);
    const int nfree = (F.G - NMODCU) * NWAVES, early = balanced ? R0 * nfree : 0;
    for (int rho = 0;; ++rho) {
        int it;
        if (!balanced) it = rho * NGW + gw;
        else if (rho < R0) { if (F.vcu < NMODCU) continue; it = rho * nfree + (F.vcu - NMODCU) * NWAVES + F.wave; }
        else it = early + (rho - R0) * NGW + gw;
        if (it >= NITEMS) break;
        int r = it;
        if (r < I_G) { p0_transpose_item(a.in[5], D, FF, w.WGU1, 1, scr, r, F.lane); continue; } r -= I_G;
        if (r < I_G) { p0_transpose_item(a.in[6], D, FF, w.WGU1, 2, scr, r, F.lane); continue; } r -= I_G;
        if (r < I_D) { p0_transpose_item(a.in[7], FF, D, w.WD1, 0, scr, r, F.lane); continue; } r -= I_D;
        if (r < I_IN) { p0_transpose_item(a.in[9], D, NIN, w.WIN, 0, scr, r, F.lane); continue; } r -= I_IN;
        if (r < I_AB) { p0_transpose_item(a.in[17], DA, D, w.WA, 0, scr, r, F.lane); continue; } r -= I_AB;
        if (r < I_AB) { p0_transpose_item(a.in[18], DB, D, w.WB, 0, scr, r, F.lane); continue; } r -= I_AB;
        if (r < I_O) { p0_transpose_item(a.in[19], D, D, w.WO, 0, scr, r, F.lane); continue; } r -= I_O;
        if (r < I_G) { p0_transpose_item(a.in[21], D, FF, w.WGU2, 1, scr, r, F.lane); continue; } r -= I_G;
        if (r < I_G) { p0_transpose_item(a.in[22], D, FF, w.WGU2, 2, scr, r, F.lane); continue; } r -= I_G;
        p0_transpose_item(a.in[23], FF, D, w.WD2, 0, scr, r, F.lane);
    }
    for (int i = (F.vcu * NWAVES * 64 + F.tid); i < NG * CHUNK * CHUNK; i += F.G * NWAVES * 64) { const int s = i & 127, t = (i >> 7) & 127; w.WSP[i] = (bf16_t)f2bf(s <= t ? a.in[12][i] : 0.f); }
}
__device__ __forceinline__ void p1_cb_item(const Frame& F, const float* sh  , const bf16_t* Wt, int N, float* cb, int item) {
    const int r = F.lane & 15, g = F.lane >> 4, R0 = item * 16;
    const bf16_t* wp = Wt + (size_t)(R0 + r) * D + 8 * g; const float* sp = sh + r * NMOD + 8 * g;
    f32x4 acc = (f32x4){0.f, 0.f, 0.f, 0.f};
#pragma unroll 16
    for (int ks = 0; ks < D / 32; ++ks) {
        const bf16x8 wa = *(const bf16x8*)(wp + 32 * ks);
        const f32x4 s0 = *(const f32x4*)(sp + 32 * ks), s1 = *(const f32x4*)(sp + 32 * ks + 4);
        const float sv[8] = {s0[0], s0[1], s0[2], s0[3], s1[0], s1[1], s1[2], s1[3]};
        unsigned hi[4], lo[4];
#pragma unroll
        for (int i = 0; i < 4; ++i) { const unsigned h0 = f2bf(sv[2 * i]), h1 = f2bf(sv[2 * i + 1]); hi[i] = h0 | (h1 << 16);
            lo[i] = f2bf(sv[2 * i] - __uint_as_float(h0 << 16)) | (f2bf(sv[2 * i + 1] - __uint_as_float(h1 << 16)) << 16); }
        acc = __builtin_amdgcn_mfma_f32_16x16x32_bf16(wa, __builtin_bit_cast(bf16x8, (u32x4){hi[0], hi[1], hi[2], hi[3]}), acc, 0, 0, 0);
        acc = __builtin_amdgcn_mfma_f32_16x16x32_bf16(wa, __builtin_bit_cast(bf16x8, (u32x4){lo[0], lo[1], lo[2], lo[3]}), acc, 0, 0, 0);
    }
    *(f32x4*)(cb + (size_t)r * N + R0 + 4 * g) = acc;
}
__device__ __forceinline__ void xpass(const Frame& F, const Args& a, const WsPtrs& w) {
    const int gw = F.vcu * NWAVES + F.wave, NGW = F.G * NWAVES;
    for (int blk = gw; blk < M / 16; blk += NGW) {
        const int m0 = blk * 16, b = m0 >> 11;
        f32x4 gsv[2][2], shv[2][2];
#pragma unroll
        for (int j = 0; j < 2; ++j)
#pragma unroll
            for (int h = 0; h < 2; ++h) { const int k = j * 512 + F.lane * 8 + h * 4; gsv[j][h] = *(const f32x4*)(a.in[4] + k) * (*(const f32x4*)(w.mods + b * NMOD + 1 * D + k) + 1.0f); shv[j][h] = *(const f32x4*)(w.mods + b * NMOD + k); }
        for (int r4 = 0; r4 < 16; r4 += 4) {
            f32x4 v[4][2][2];
#pragma unroll
            for (int r = 0; r < 4; ++r)
#pragma unroll
                for (int j = 0; j < 2; ++j) { const float* xr = a.in[0] + (size_t)(m0 + r4 + r) * D + j * 512 + F.lane * 8; v[r][j][0] = *(const f32x4*)xr; v[r][j][1] = *(const f32x4*)(xr + 4); }
#pragma unroll
            for (int r = 0; r < 4; ++r) { float s = 0.f;
#pragma unroll
                for (int j = 0; j < 2; ++j) { const f32x4 v0 = v[r][j][0], v1 = v[r][j][1];
                    s += (v0[0] * v0[0] + v0[1] * v0[1]) + (v0[2] * v0[2] + v0[3] * v0[3]) + (v1[0] * v1[0] + v1[1] * v1[1]) + (v1[2] * v1[2] + v1[3] * v1[3]); }
                s = wave_sum(s); const float rs = __builtin_amdgcn_rsqf(s * (1.0f / D) + EPS);
#pragma unroll
                for (int j = 0; j < 2; ++j) { const f32x4 a0 = v[r][j][0] * rs * gsv[j][0] + shv[j][0], a1 = v[r][j][1] * rs * gsv[j][1] + shv[j][1];
                    *(u32x4*)(w.XN + (size_t)(m0 + r4 + r) * D + j * 512 + F.lane * 8) = (u32x4){cvt_pk_bf16(a0[0], a0[1]), cvt_pk_bf16(a0[2], a0[3]), cvt_pk_bf16(a1[0], a1[1]), cvt_pk_bf16(a1[2], a1[3])}; } }
        }
    }
}
__device__ __forceinline__ void p1_phase(const Frame& F, const Args& a, const WsPtrs& w) {
    xpass(F, a, w);
    const int gw = F.vcu * NWAVES + F.wave, NGW = F.G * NWAVES;
    constexpr int I1 = NGU / 16, I2 = NIN / 16;
    for (int it = gw; it < I1 + I2; it += NGW) {
        if (it < I2) p1_cb_item(F, w.mods + 3 * D, w.WIN, NIN, w.cb2, it);
        else p1_cb_item(F, w.mods + 6 * D, w.WGU2, NGU, w.cb3, it - I2);
    }
}
__device__ __forceinline__ void cb3_items(const Frame& F, const WsPtrs& w) {
    const int gw = F.vcu * NWAVES + F.wave, NGW = F.G * NWAVES;
    for (int it = gw; it < NGU / 16; it += NGW) p1_cb_item(F, w.mods + 6 * D, w.WGU2, NGU, w.cb3, it);
}

__global__ void k_vln(const bf16_t* P, const float* g, const float* bta, bf16_t* vn) {
    const int m = (blockIdx.x * blockDim.x + threadIdx.x) >> 6, lane = threadIdx.x & 63;
    if (m >= M) return;
    float v[8], s = 0.f;
    for (int i = 0; i < 8; ++i) { v[i] = bf2f(P[(size_t)m * NIN + PC_V + i * 64 + lane]); s += v[i]; }
    for (int o = 1; o < 64; o <<= 1) s += __shfl_xor(s, o);
    const float mu = s * (1.0f / DA); float q = 0.f;
    for (int i = 0; i < 8; ++i) { v[i] -= mu; q += v[i] * v[i]; }
    for (int o = 1; o < 64; o <<= 1) q += __shfl_xor(q, o);
    const float rs = rsqrtf(q * (1.0f / DA) + EPS);
    for (int i = 0; i < 8; ++i) { const int c = i * 64 + lane; vn[(size_t)m * DA + c] = f2bf(v[i] * rs * g[c] + bta[c]); }
}
__global__ void k_sgu(const bf16_t* P, const bf16_t* vn, const bf16_t* wsp, const float* bsp, bf16_t* mix) {
    const int ch = threadIdx.x + (blockIdx.x & 1) * 256, m = blockIdx.x >> 1;
    const int t = m & 127, g = ch >> 7, m0 = m - t;
    float z = 0.f;
    for (int s = 0; s <= t; ++s) z += bf2f(wsp[(g * 128 + t) * 128 + s]) * bf2f(vn[(size_t)(m0 + s) * DA + ch]);
    z += bsp[g * 128 + t];
    mix[(size_t)m * D + ch] = f2bf(bf2f(P[(size_t)m * NIN + PC_U + ch]) * z);
}
__global__ __launch_bounds__(128) void k_attn(const bf16_t* P, const float* gq, const float* gk, const float* sinks, bf16_t* mix) {
    const int i = threadIdx.x, hq = blockIdx.x & 7, n = (blockIdx.x >> 3) & 15, b = blockIdx.x >> 7, h = hq >> 2;
    const int m = b * SEQ + n * 128 + i;
    float q[64], o[64]; float s2 = 0.f;
    for (int d = 0; d < 64; ++d) { q[d] = bf2f(P[(size_t)m * NIN + PC_Q + hq * 64 + d]); s2 += q[d] * q[d]; o[d] = 0.f; }
    const float qs = rsqrtf(s2 * (1.0f / 64) + EPS) * 0.125f;
    for (int d = 0; d < 64; ++d) q[d] *= qs * gq[d];
    const float sink = sinks[hq];
    float mx = sink, l = 1.0f;
    for (int dj = 127; dj >= 0; --dj) {
        const int kp = n * 128 + i - dj; if (kp < 0) continue;
        const bf16_t* kr = P + (size_t)(b * SEQ + kp) * NIN + PC_K + h * 64;
        float kk[64], k2 = 0.f;
        for (int d = 0; d < 64; ++d) { kk[d] = bf2f(kr[d]); k2 += kk[d] * kk[d]; }
        const float ks = rsqrtf(k2 * (1.0f / 64) + EPS); float sc = 0.f;
        for (int d = 0; d < 64; ++d) sc += q[d] * kk[d] * gk[d];
        sc *= ks;
        const float nm = fmaxf(mx, sc), f = __expf(mx - nm), p = __expf(sc - nm);
        const bf16_t* vr = P + (size_t)(b * SEQ + kp) * NIN + PC_VV + h * 64;
        for (int d = 0; d < 64; ++d) o[d] = o[d] * f + p * bf2f(vr[d]);
        l = l * f + p; mx = nm;
    }
    const float il = 1.0f / l;
    for (int d = 0; d < 64; ++d) mix[(size_t)m * D + 512 + hq * 64 + d] = f2bf(o[d] * il);
}


typedef short s16x4 __attribute__((ext_vector_type(4)));
typedef short v4i16_t __attribute__((ext_vector_type(4)));
__device__ __forceinline__ s16x4 vtr(const LAS unsigned char* p) { return __builtin_bit_cast(s16x4, __builtin_amdgcn_ds_read_tr16_b64_v4i16((LAS v4i16_t*)p)); }
__device__ __forceinline__ bf16x8 cat4(s16x4 a, s16x4 b) { return (bf16x8){a[0], a[1], a[2], a[3], b[0], b[1], b[2], b[3]}; }
__device__ __forceinline__ void unpack8(const u32x4 v, float (&f)[8]) { f[0] = bflo(v[0]); f[1] = bfhi(v[0]); f[2] = bflo(v[1]); f[3] = bfhi(v[1]); f[4] = bflo(v[2]); f[5] = bfhi(v[2]); f[6] = bflo(v[3]); f[7] = bfhi(v[3]); }

constexpr int ATT_K_OFF = 0, ATT_V_OFF = 32768;
static_assert(4 * 128 * 256 <= RING_BYTES, "mixer LDS");

struct KVRaw { u32x4 k[4], v[4]; };
__device__ __forceinline__ void attn_load_kv(KVRaw& r, const Frame& F, const bf16_t* P, int b, int n, int h) {
    const int ch = F.tid & 7;
#pragma unroll
    for (int it = 0; it < 4; ++it) {
        const int j = (F.tid >> 3) + 64 * it, kp = (n - 1) * 128 + j;
        r.k[it] = (u32x4){0u, 0u, 0u, 0u}; r.v[it] = (u32x4){0u, 0u, 0u, 0u};
        if (kp >= 0) { const bf16_t* rowp = P + (size_t)(b * SEQ + kp) * NIN; r.k[it] = *(const u32x4*)(rowp + PC_K + h * 64 + ch * 8); r.v[it] = *(const u32x4*)(rowp + PC_VV + h * 64 + ch * 8); }
    }
}
__device__ __forceinline__ void attn_unit(const Frame& F, const bf16_t* P, bf16_t* MIX, const float* gq, const float* gk, const float* sinks, int b, int n, int h, KVRaw& raw, bool has_next, int nb, int nn, int nh) {
    const int lane = F.lane, w = F.wave, r = lane & 15, g = lane >> 4;
    LAS unsigned char* Kt = F.lds + RING_OFF + ATT_K_OFF; LAS unsigned char* Vt = F.lds + RING_OFF + ATT_V_OFF;
    const int qrow = b * SEQ + n * 128 + 16 * w + r;
    u32x4 qraw[4][2];
#pragma unroll
    for (int hh = 0; hh < 4; ++hh) { const bf16_t* qp = P + (size_t)qrow * NIN + PC_Q + (4 * h + hh) * 64; qraw[hh][0] = *(const u32x4*)(qp + 8 * g); qraw[hh][1] = *(const u32x4*)(qp + 32 + 8 * g); }
    {
        const int ch = F.tid & 7;
        const f32x4 gk0 = *(const f32x4*)(gk + ch * 8), gk1 = *(const f32x4*)(gk + ch * 8 + 4);
#pragma unroll
        for (int it = 0; it < 4; ++it) {
            const int j = (F.tid >> 3) + 64 * it;
            float kf[8]; unpack8(raw.k[it], kf);
            float ss = (kf[0] * kf[0] + kf[1] * kf[1]) + (kf[2] * kf[2] + kf[3] * kf[3]) + (kf[4] * kf[4] + kf[5] * kf[5]) + (kf[6] * kf[6] + kf[7] * kf[7]);
            ss += __shfl_xor(ss, 1); ss += __shfl_xor(ss, 2); ss += __shfl_xor(ss, 4);
            const float rs = __builtin_amdgcn_rsqf(ss * (1.0f / HD) + EPS);
            const u32x4 kn = (u32x4){cvt_pk_bf16(kf[0] * rs * gk0[0], kf[1] * rs * gk0[1]), cvt_pk_bf16(kf[2] * rs * gk0[2], kf[3] * rs * gk0[3]),
                                     cvt_pk_bf16(kf[4] * rs * gk1[0], kf[5] * rs * gk1[1]), cvt_pk_bf16(kf[6] * rs * gk1[2], kf[7] * rs * gk1[3])};
            *(LAS u32x4*)(Kt + j * 128 + 16 * (ch ^ (j & 7))) = kn;
            const int x = (j >> 1) & 3; const u32x4 vv = raw.v[it];
            *(LAS u32x4*)(Vt + j * 128 + 16 * (ch ^ (x >> 1))) = (x & 1) ? (u32x4){vv[2], vv[3], vv[0], vv[1]} : vv;
        }
    }
    __syncthreads();
    if (has_next) attn_load_kv(raw, F, P, nb, nn, nh);
    const int q4 = (lane & 15) >> 2, p4 = lane & 3;
    const int vx = (2 * g + (q4 >> 1)) & 3;
#pragma unroll
    for (int hh = 0; hh < 4; ++hh) {
        const int hq = 4 * h + hh;
        bf16x8 qa0, qa1;
        {
            float a[8], c[8]; unpack8(qraw[hh][0], a); unpack8(qraw[hh][1], c);
            float ss = 0.f;
#pragma unroll
            for (int i = 0; i < 8; ++i) ss += a[i] * a[i] + c[i] * c[i];
            ss += __shfl_xor(ss, 16); ss += __shfl_xor(ss, 32);
            const float qs = __builtin_amdgcn_rsqf(ss * (1.0f / HD) + EPS) * (0.125f * LOG2E);
            const f32x4 ga0 = *(const f32x4*)(gq + 8 * g), ga1 = *(const f32x4*)(gq + 8 * g + 4), gc0 = *(const f32x4*)(gq + 32 + 8 * g), gc1 = *(const f32x4*)(gq + 32 + 8 * g + 4);
            const u32x4 p0 = (u32x4){cvt_pk_bf16(a[0] * qs * ga0[0], a[1] * qs * ga0[1]), cvt_pk_bf16(a[2] * qs * ga0[2], a[3] * qs * ga0[3]), cvt_pk_bf16(a[4] * qs * ga1[0], a[5] * qs * ga1[1]), cvt_pk_bf16(a[6] * qs * ga1[2], a[7] * qs * ga1[3])};
            const u32x4 p1 = (u32x4){cvt_pk_bf16(c[0] * qs * gc0[0], c[1] * qs * gc0[1]), cvt_pk_bf16(c[2] * qs * gc0[2], c[3] * qs * gc0[3]), cvt_pk_bf16(c[4] * qs * gc1[0], c[5] * qs * gc1[1]), cvt_pk_bf16(c[6] * qs * gc1[2], c[7] * qs * gc1[3])};
            qa0 = __builtin_bit_cast(bf16x8, p0); qa1 = __builtin_bit_cast(bf16x8, p1);
        }
        f32x4 sacc[10];
#pragma unroll
        for (int fp = 0; fp < 9; ++fp) {
            const int f = (w + fp) < 16 ? (w + fp) : 15; const LAS unsigned char* kr = Kt + (16 * f + r) * 128;
            const bf16x8 k0 = *(const LAS bf16x8*)(kr + 16 * (g ^ (r & 7))), k1 = *(const LAS bf16x8*)(kr + 16 * ((4 + g) ^ (r & 7)));
            sacc[fp] = __builtin_amdgcn_mfma_f32_16x16x32_bf16(k0, qa0, (f32x4){0.f, 0.f, 0.f, 0.f}, 0, 0, 0);
            sacc[fp] = __builtin_amdgcn_mfma_f32_16x16x32_bf16(k1, qa1, sacc[fp], 0, 0, 0);
        }
        const float sink2 = sinks[hq] * LOG2E;
        float mx = sink2;
#pragma unroll
        for (int fp = 0; fp < 9; ++fp) {
            const bool fvalid = (n > 0) || (w + fp >= 8);
#pragma unroll
            for (int e = 0; e < 4; ++e) { const int rel = 16 * fp + 4 * g + e - r;
                const bool valid = fvalid && (fp == 0 ? (rel >= 1) : (fp == 8 ? (rel <= 128) : true));
                const float t = valid ? sacc[fp][e] : -INFINITY; sacc[fp][e] = t; mx = fmaxf(mx, t); } }
        mx = fmaxf(mx, __shfl_xor(mx, 16)); mx = fmaxf(mx, __shfl_xor(mx, 32));
        float l = 0.f;
#pragma unroll
        for (int fp = 0; fp < 9; ++fp)
#pragma unroll
            for (int e = 0; e < 4; ++e) { const float p = __builtin_amdgcn_exp2f(sacc[fp][e] - mx); sacc[fp][e] = p; l += p; }
        sacc[9] = (f32x4){0.f, 0.f, 0.f, 0.f};
        l += __shfl_xor(l, 16); l += __shfl_xor(l, 32);
        l += __builtin_amdgcn_exp2f(sink2 - mx);
        const float inv = __builtin_amdgcn_rcpf(l);
        f32x4 oacc[4];
#pragma unroll
        for (int df = 0; df < 4; ++df) oacc[df] = (f32x4){0.f, 0.f, 0.f, 0.f};
#pragma unroll
        for (int s = 0; s < 5; ++s) {
            const u32x4 pw = (u32x4){cvt_pk_bf16(sacc[2 * s][0], sacc[2 * s][1]), cvt_pk_bf16(sacc[2 * s][2], sacc[2 * s][3]), cvt_pk_bf16(sacc[2 * s + 1][0], sacc[2 * s + 1][1]), cvt_pk_bf16(sacc[2 * s + 1][2], sacc[2 * s + 1][3])};
            const bf16x8 pb = __builtin_bit_cast(bf16x8, pw);
            s16x4 vt[2][4];
#pragma unroll
            for (int t = 0; t < 2; ++t) { const int f = (w + 2 * s + t) < 16 ? (w + 2 * s + t) : 15;
                const LAS unsigned char* vr = Vt + (16 * f + 4 * g + q4) * 128;
#pragma unroll
                for (int df = 0; df < 4; ++df) vt[t][df] = vtr(vr + 8 * ((4 * p4 + df) ^ vx)); }
#pragma unroll
            for (int df = 0; df < 4; ++df) oacc[df] = __builtin_amdgcn_mfma_f32_16x16x32_bf16(cat4(vt[0][df], vt[1][df]), pb, oacc[df], 0, 0, 0);
        }
        bf16_t* op = MIX + (size_t)qrow * D + 512 + hq * 64 + 16 * g;
        const u32x4 o0 = (u32x4){cvt_pk_bf16(oacc[0][0] * inv, oacc[0][1] * inv), cvt_pk_bf16(oacc[0][2] * inv, oacc[0][3] * inv), cvt_pk_bf16(oacc[1][0] * inv, oacc[1][1] * inv), cvt_pk_bf16(oacc[1][2] * inv, oacc[1][3] * inv)};
        const u32x4 o1 = (u32x4){cvt_pk_bf16(oacc[2][0] * inv, oacc[2][1] * inv), cvt_pk_bf16(oacc[2][2] * inv, oacc[2][3] * inv), cvt_pk_bf16(oacc[3][0] * inv, oacc[3][1] * inv), cvt_pk_bf16(oacc[3][2] * inv, oacc[3][3] * inv)};
        *(u32x4*)op = o0; *(u32x4*)(op + 8) = o1;
    }
    __syncthreads();
}

__device__ __forceinline__ void sgu_unit(const Frame& F, const bf16_t* P, bf16_t* MIX, const bf16_t* WSP, const float* gln, const float* bln, const float* bsp, int b, int n, unsigned char* g_ws_) {
    const int lane = F.lane, w = F.wave, gq = lane >> 4;
    LAS unsigned char* Vn = F.lds + RING_OFF;
    const int row0 = b * SEQ + n * 128;
    {
        const f32x4 g0 = *(const f32x4*)(gln + lane * 8), g1 = *(const f32x4*)(gln + lane * 8 + 4), b0 = *(const f32x4*)(bln + lane * 8), b1 = *(const f32x4*)(bln + lane * 8 + 4);
        u32x4 xv[16];
#pragma unroll
        for (int rr = 0; rr < 16; ++rr) xv[rr] = *(const u32x4*)(P + (size_t)(row0 + 16 * w + rr) * NIN + PC_V + lane * 8);
        float red[16];
#pragma unroll
        for (int rr = 0; rr < 16; ++rr) red[rr] = ((bflo(xv[rr][0]) + bfhi(xv[rr][0])) + (bflo(xv[rr][1]) + bfhi(xv[rr][1]))) + ((bflo(xv[rr][2]) + bfhi(xv[rr][2])) + (bflo(xv[rr][3]) + bfhi(xv[rr][3])));
#define SGU_TREDUCE(v) do { \
        _Pragma("unroll") for (int i = 0; i < 8; ++i) { const bool hi_ = lane & 1; const float keep = hi_ ? v[2 * i + 1] : v[2 * i], send = hi_ ? v[2 * i] : v[2 * i + 1]; v[i] = keep + __shfl_xor(send, 1); } \
        _Pragma("unroll") for (int i = 0; i < 4; ++i) { const bool hi_ = lane & 2; const float keep = hi_ ? v[2 * i + 1] : v[2 * i], send = hi_ ? v[2 * i] : v[2 * i + 1]; v[i] = keep + __shfl_xor(send, 2); } \
        _Pragma("unroll") for (int i = 0; i < 2; ++i) { const bool hi_ = lane & 4; const float keep = hi_ ? v[2 * i + 1] : v[2 * i], send = hi_ ? v[2 * i] : v[2 * i + 1]; v[i] = keep + __shfl_xor(send, 4); } \
        { const bool hi_ = lane & 8; const float keep = hi_ ? v[1] : v[0], send = hi_ ? v[0] : v[1]; v[0] = keep + __shfl_xor(send, 8); } \
        v[0] += __shfl_xor(v[0], 16); v[0] += __shfl_xor(v[0], 32); } while (0)
        SGU_TREDUCE(red);
        const float mu_l = red[0] * (1.0f / DA);
#pragma unroll
        for (int rr = 0; rr < 16; ++rr) { float q = 0.f; const float m_ = __shfl(mu_l, rr);
#pragma unroll
            for (int i = 0; i < 4; ++i) { const float d0 = bflo(xv[rr][i]) - m_, d1 = bfhi(xv[rr][i]) - m_; q += d0 * d0 + d1 * d1; }
            red[rr] = q; }
        SGU_TREDUCE(red);
#undef SGU_TREDUCE
        const float rs_l = __builtin_amdgcn_rsqf(red[0] * (1.0f / DA) + EPS);
        const int q = lane >> 4, c = lane & 15;
#pragma unroll
        for (int rr = 0; rr < 16; ++rr) {
            const float rs = __shfl(rs_l, rr), m_ = __shfl(mu_l, rr); const int s = 16 * w + rr;
            const unsigned o0 = cvt_pk_bf16((bflo(xv[rr][0]) - m_) * rs * g0[0] + b0[0], (bfhi(xv[rr][0]) - m_) * rs * g0[1] + b0[1]);
            const unsigned o1 = cvt_pk_bf16((bflo(xv[rr][1]) - m_) * rs * g0[2] + b0[2], (bfhi(xv[rr][1]) - m_) * rs * g0[3] + b0[3]);
            const unsigned o2 = cvt_pk_bf16((bflo(xv[rr][2]) - m_) * rs * g1[0] + b1[0], (bfhi(xv[rr][2]) - m_) * rs * g1[1] + b1[1]);
            const unsigned o3 = cvt_pk_bf16((bflo(xv[rr][3]) - m_) * rs * g1[2] + b1[2], (bfhi(xv[rr][3]) - m_) * rs * g1[3] + b1[3]);
            const int x = (s & 3) | (((s >> 3) & 1) << 2);
            *(LAS u32x4*)(Vn + q * 32768 + s * 256 + 16 * (c ^ (x >> 1))) = (x & 1) ? (u32x4){o2, o3, o0, o1} : (u32x4){o0, o1, o2, o3};
        }
    }
    __syncthreads(); STAMP(2);
    int lane_ = lane; asm volatile("" : "+v"(lane_));
    const int q4 = (lane_ & 15) >> 2, p4 = lane_ & 3;
    const int vx = q4 | ((gq & 1) << 2);
    bf16x8 wbn[4]; u32x4 uvn[4]; float biasn;
#define SGU_TB(G) (((G) < 2) ? w : 7 - w)
#define SGU_LOAD(G) do { const int t_ = 16 * SGU_TB(G) + (lane_ & 15); const bf16_t* wrow_ = WSP + (size_t)((G) * 128 + t_) * 128 + 8 * gq; const bf16_t* up_ = P + (size_t)(row0 + t_) * NIN + PC_U + (G) * 128 + 32 * gq; \
        _Pragma("unroll") for (int k = 0; k < 4; ++k) { wbn[k] = *(const bf16x8*)(wrow_ + 32 * k); uvn[k] = *(const u32x4*)(up_ + 8 * k); } biasn = bsp[(G) * 128 + t_]; } while (0)
    SGU_LOAD(0);
#pragma unroll
    for (int g = 0; g < NG; ++g) {
        f32x4 z[8];
#pragma unroll
        for (int cf = 0; cf < 8; ++cf) z[cf] = (f32x4){0.f, 0.f, 0.f, 0.f};
        bf16x8 wb[4]; u32x4 uv[4];
#pragma unroll
        for (int k = 0; k < 4; ++k) { wb[k] = wbn[k]; uv[k] = uvn[k]; }
        const float bias = biasn; const int tb = SGU_TB(g), t = 16 * tb + (lane_ & 15);
        if (g + 1 < NG) SGU_LOAD(g + 1);
#pragma unroll
        for (int ks = 0; ks < 4; ++ks) {
            if (ks <= (tb >> 1)) {
                s16x4 vt[2][8];
#pragma unroll
                for (int t2 = 0; t2 < 2; ++t2) { const LAS unsigned char* vr = Vn + g * 32768 + (32 * ks + 8 * gq + 4 * t2 + q4) * 256;
#pragma unroll
                    for (int cf = 0; cf < 8; ++cf) vt[t2][cf] = vtr(vr + 8 * ((8 * p4 + cf) ^ vx)); }
#pragma unroll
                for (int cf = 0; cf < 8; ++cf) z[cf] = __builtin_amdgcn_mfma_f32_16x16x32_bf16(cat4(vt[0][cf], vt[1][cf]), wb[ks], z[cf], 0, 0, 0);
            }
        }
        bf16_t* op = MIX + (size_t)(row0 + t) * D + g * 128 + 32 * gq;
#pragma unroll
        for (int k = 0; k < 4; ++k) {
            float uf[8]; unpack8(uv[k], uf);
            const f32x4 za = z[2 * k] + bias, zb = z[2 * k + 1] + bias;
            *(u32x4*)(op + 8 * k) = (u32x4){cvt_pk_bf16(uf[0] * za[0], uf[1] * za[1]), cvt_pk_bf16(uf[2] * za[2], uf[3] * za[3]), cvt_pk_bf16(uf[4] * zb[0], uf[5] * zb[1]), cvt_pk_bf16(uf[6] * zb[2], uf[7] * zb[3])};
        }
    }
#undef SGU_LOAD
#undef SGU_TB
    STAMP(3);
    __syncthreads();
}

__device__ __forceinline__ void mixer_phase(const Frame& F, const Args& a, const WsPtrs& w) {
    unsigned char* g_ws_ = a.ws; (void)g_ws_; STAMP(0);
    constexpr int NATT = BATCH * NCH * NKVH, NSGU = BATCH * NCH;
    {
        KVRaw raw;
        int u = F.vcu;
        if (u < NATT) attn_load_kv(raw, F, w.P, u >> 5, (u >> 1) & 15, u & 1);
        for (; u < NATT; u += F.G) {
            const int un = u + F.G; const bool has_next = un < NATT;
            attn_unit(F, w.P, w.MIX, a.in[14], a.in[15], a.in[16], u >> 5, (u >> 1) & 15, u & 1, raw, has_next, un >> 5, (un >> 1) & 15, un & 1);
        }
    }
    STAMP(1);
    for (int u = F.vcu; u < NSGU; u += F.G) sgu_unit(F, w.P, w.MIX, w.WSP, a.in[10], a.in[11], a.in[13], u >> 4, u & 15, a.ws);
    STAMP(4);
}

__global__ void __launch_bounds__(NWAVES * 64, 2) mega_fwd(Args args) {
    extern __shared__ __attribute__((aligned(16))) unsigned char lds[];
    Frame F;
    F.lds = (LAS unsigned char*)lds;
    F.MISC = (volatile LAS unsigned*)(F.lds + MISC_OFF);
    F.tid = threadIdx.x; F.lane = F.tid & 63; F.wave = __builtin_amdgcn_readfirstlane(F.tid >> 6);
    F.G = gridDim.x; { const int bx = blockIdx.x; F.vcu = (F.G % 8 == 0) ? (bx % 8) * (F.G / 8) + bx / 8 : bx; }
    unsigned char* ws = args.ws;
    WsPtrs w;
    w.mods = (float*)(ws + WS_MODS); w.cb1 = (float*)(ws + WS_CB1); w.cb2 = (float*)(ws + WS_CB2); w.cb3 = (float*)(ws + WS_CB3);
    w.ss1 = (float*)(ws + WS_SS1); w.ss2 = (float*)(ws + WS_SS2); w.ss3 = (float*)(ws + WS_SS3);
    w.WGU1 = (bf16_t*)(ws + WS_WGU1); w.WD1 = (bf16_t*)(ws + WS_WD1); w.WIN = (bf16_t*)(ws + WS_WIN); w.WA = (bf16_t*)(ws + WS_WA); w.WB = (bf16_t*)(ws + WS_WB);
    w.WO = (bf16_t*)(ws + WS_WO); w.WGU2 = (bf16_t*)(ws + WS_WGU2); w.WD2 = (bf16_t*)(ws + WS_WD2); w.WSP = (bf16_t*)(ws + WS_WSP);
    w.H16 = (_Float16*)(ws + WS_H16); w.XN = (bf16_t*)(ws + WS_XN); w.MIX = (bf16_t*)(ws + WS_MIX); w.MERGED = (bf16_t*)(ws + WS_MERGED); w.ACT = (bf16_t*)(ws + WS_ACT); w.P = (bf16_t*)(ws + WS_P);
    for (int u = F.tid; u < (LDS_BYTES - LDSCTL_OFF) / 4; u += NWAVES * 64) ((LAS unsigned*)(F.lds + LDSCTL_OFF))[u] = 0u;
    __syncthreads();
    XcdBarrier bar = xcd_barrier_post((unsigned*)(ws + WS_CTL) + CW_BAR + args.li * XCD_BAR_WORDS, F.MISC + 8);
    const int lo = args.ph_lo, hi = args.ph_hi;
#define IN(k) (lo <= (k) && (k) < hi)
#ifdef PROBE_WORK
#define SEAM(k) do { if ((k) == PROBE_LO) epi_ticks = __builtin_amdgcn_s_memrealtime() - pr_t0; if (IN(k) && IN((k) + 1)) xcd_barrier(bar); } while (0)
#else
#define SEAM(k) do { if (IN(k) && IN((k) + 1)) xcd_barrier(bar); } while (0)
#endif
    const int cid = (int)blockIdx.x;
    float* out = args.out;
    unsigned long long epi_ticks = 0;
#ifdef PROBE_LO
    unsigned long long pr_t0 = 0, pr_t1 = 0;
#ifdef PROBE_CLOCK
    unsigned long long pr_c0 = 0, pr_c1 = 0;
#define PR_BEGIN(k) do { if ((k) == PROBE_LO) { pr_t0 = __builtin_amdgcn_s_memrealtime(); pr_c0 = __builtin_amdgcn_s_memtime(); } } while (0)
#else
#define PR_BEGIN(k) do { if ((k) == PROBE_LO) { pr_t0 = __builtin_amdgcn_s_memrealtime(); epi_ticks = 0; } } while (0)
#endif
#ifdef PROBE_CLOCK
#define PR_END(k) do { if ((k) == PROBE_HI) { pr_c1 = __builtin_amdgcn_s_memtime(); pr_t1 = __builtin_amdgcn_s_memrealtime(); pr_t1 = pr_t0 + (unsigned long long)((double)(pr_c1 - pr_c0) / (double)(pr_t1 - pr_t0) * 10000.0); } } while (0)
#elif defined(PROBE_RED)
#define PR_END(k) do { if ((k) == PROBE_HI && F.tid == 0) { atomicMax((unsigned*)(ws + WS_CTL) + 64, (unsigned)epi_ticks); atomicAdd((unsigned*)(ws + WS_CTL) + 65, (unsigned)epi_ticks); } } while (0)
#elif defined(PROBE_EPI)
#define PR_END(k) do { if ((k) == PROBE_HI) { pr_t1 = pr_t0 + epi_ticks; } } while (0)
#else
#define PR_END(k) do { if ((k) == PROBE_HI) pr_t1 = __builtin_amdgcn_s_memrealtime(); } while (0)
#endif
#else
#define PR_BEGIN(k) do {} while (0)
#define PR_END(k) do {} while (0)
#endif

    if (IN(0)) { PR_BEGIN(0); p0_prologue(F, args, w); SEAM(0); PR_END(0); }
    if (IN(1)) { PR_BEGIN(1); p1_phase(F, args, w); SEAM(1); PR_END(1); }
    if (IN(2)) { PR_BEGIN(2);
        pg8::Gemm g{w.XN, w.XN, w.WGU1, w.WGU1, D, D, D}; pg8::StaticOrder S; S.init(M, NGU, F.G, cid);
        EpiGU<true> E{w.ACT, nullptr, nullptr};
        pg8::gemm_phase(F.lds + RING_OFF, g, S, E, epi_ticks); SEAM(2); PR_END(2);
    }
    if (IN(3)) { PR_BEGIN(3);
        pg8::Gemm g{w.ACT, w.ACT, w.WD1, w.WD1, FF, FF, FF}; pg8::StaticOrder S; S.init(M, D, F.G, cid);
        EpiRes<true, false, true> E{args.in[0], w.H16, w.mods + 2 * D, args.in[8], w.mods + 4 * D, w.XN, w.ss2, (LAS float*)(F.lds + RED_OFF), 0.5f};
#ifdef PROBE_SKEW
        if (blockIdx.x & 1) { const unsigned long long t0_ = __builtin_amdgcn_s_memrealtime(); while (__builtin_amdgcn_s_memrealtime() - t0_ < (unsigned long long)(PROBE_SKEW * 100)) __builtin_amdgcn_s_sleep(8); }
#endif
        pg8::gemm_phase(F.lds + RING_OFF, g, S, E, epi_ticks); SEAM(3); PR_END(3);
    }
    if (IN(4)) { PR_BEGIN(4);
        pg8::Gemm g{w.XN, w.XN, w.WIN, w.WIN, D, D, D}; pg8::StaticOrder S; S.init(M, NIN, F.G, cid);
        EpiWin E{w.P, w.ss2, w.cb2};
        pg8::gemm_phase(F.lds + RING_OFF, g, S, E, epi_ticks);
        SEAM(4); PR_END(4);
    }
    if (IN(5)) { PR_BEGIN(5);
        mixer_phase(F, args, w);
        SEAM(5); PR_END(5);
#ifdef PROBE_STAMPS
        if (blockIdx.x == 0 && F.tid == 0) { const unsigned long long* st_ = (const unsigned long long*)(ws + WS_CTL) + 40; pr_t0 = st_[PROBE_SA]; pr_t1 = st_[PROBE_SB]; }
#endif
    }
    if (IN(6)) { PR_BEGIN(6);
        pg8::Gemm g{w.MIX, w.MIX + 512, w.WA, w.WB, D, DA, DA}; pg8::StaticOrder S; S.init(M, D, F.G, cid, 2);
        EpiBranch E{w.P, w.MERGED};
        pg8::gemm_phase(F.lds + RING_OFF, g, S, E, epi_ticks); SEAM(6); PR_END(6);
    }
    if (IN(7)) { PR_BEGIN(7);
        pg8::Gemm g{w.MERGED, w.MERGED, w.WO, w.WO, D, D, D}; pg8::StaticOrder S; S.init(M, D, F.G, cid);
        EpiRes<true, true, true> E{w.H16, w.H16, w.mods + 5 * D, args.in[20], w.mods + 7 * D, w.XN, w.ss3, (LAS float*)(F.lds + RED_OFF), 1.0f};
        pg8::gemm_phase(F.lds + RING_OFF, g, S, E, epi_ticks); SEAM(7); PR_END(7);
    }
    if (IN(8)) { PR_BEGIN(8);
        pg8::Gemm g{w.XN, w.XN, w.WGU2, w.WGU2, D, D, D}; pg8::StaticOrder S; S.init(M, NGU, F.G, cid);
        EpiGU<false> E{w.ACT, w.ss3, w.cb3};
        pg8::gemm_phase(F.lds + RING_OFF, g, S, E, epi_ticks); SEAM(8); PR_END(8);
    }
    if (IN(9)) { PR_BEGIN(9);
        pg8::Gemm g{w.ACT, w.ACT, w.WD2, w.WD2, FF, FF, FF}; pg8::StaticOrder S; S.init(M, D, F.G, cid);
        EpiRes<false, true, false> E{w.H16, out, w.mods + 8 * D, nullptr, nullptr, nullptr, nullptr, nullptr, 0.5f};
        pg8::gemm_phase(F.lds + RING_OFF, g, S, E, epi_ticks);
#ifdef PROBE_LO
        xcd_barrier(bar); PR_END(9);
#ifdef PROBE_RED
        xcd_barrier(bar);
        if (blockIdx.x == 0 && F.tid == 0) { const unsigned mx_ = __hip_atomic_load((unsigned*)(ws + WS_CTL) + 64, RLX_AGENT), sm_ = __hip_atomic_load((unsigned*)(ws + WS_CTL) + 65, RLX_AGENT);
            pr_t0 = 0; pr_t1 = (PROBE_RED == 1) ? mx_ : sm_ / gridDim.x; }
#endif
        if (blockIdx.x == 0 && F.tid == 0) out[0] += PROBE_Q * floorf(((float)(pr_t1 - pr_t0) * 0.01f + PROBE_OFF) * (1.0f / PROBE_Q));
#endif
    }
#undef IN
#undef SEAM
}

extern "C" void kernel_launch(void* const* d_in, const int* in_sizes, int n_in, void* d_out, int out_size, void* d_ws, size_t ws_size, hipStream_t stream) {
    static int grid = 0;
    if (grid == 0) {
        if (n_in != 24 || in_sizes[0] != M * D || out_size != M * D || ws_size < WS_END) {
            fprintf(stderr, "kernel_launch: unexpected shapes (n_in %d, in0 %d, out %d, ws %zu < %zu); nothing launched\n", n_in, n_in > 0 ? in_sizes[0] : -1, out_size, ws_size, (size_t)WS_END); grid = -1; return; }
        int dev = 0, cus = 0, per_cu = 0;
        if (hipGetDevice(&dev) != hipSuccess || hipDeviceGetAttribute(&cus, hipDeviceAttributeMultiprocessorCount, dev) != hipSuccess) { fprintf(stderr, "kernel_launch: device query failed\n"); grid = -1; return; }
        if (hipFuncSetAttribute((const void*)mega_fwd, hipFuncAttributeMaxDynamicSharedMemorySize, LDS_BYTES) != hipSuccess) { fprintf(stderr, "kernel_launch: hipFuncSetAttribute failed\n"); grid = -1; return; }
        if (hipOccupancyMaxActiveBlocksPerMultiprocessor(&per_cu, (const void*)mega_fwd, NWAVES * 64, LDS_BYTES) != hipSuccess || per_cu < 1) {
            fprintf(stderr, "kernel_launch: occupancy query reports %d workgroups per CU; nothing launched\n", per_cu); (void)hipGetLastError(); grid = -1; return; }
        grid = cus;
        fprintf(stderr, "kernel_launch: grid %d (occupancy query: %d per CU)\n", grid, per_cu);
    }
    if (grid < 0) return;
    (void)hipMemsetAsync((char*)d_ws + WS_CTL, 0, CTL_BYTES, stream);
    Args a; memset(&a, 0, sizeof a);
    for (int i = 0; i < 24; ++i) a.in[i] = (const float*)d_in[i];
    a.out = (float*)d_out; a.ws = (unsigned char*)d_ws;
#if N_LAUNCHES == 1
    a.ph_lo = 0; a.ph_hi = 10; a.li = 0;
    hipLaunchKernelGGL(mega_fwd, dim3(grid), dim3(NWAVES * 64), LDS_BYTES, stream, a);
#else
    a.ph_lo = 0; a.ph_hi = 5; a.li = 0;
    hipLaunchKernelGGL(mega_fwd, dim3(grid), dim3(NWAVES * 64), LDS_BYTES, stream, a);
    {
        unsigned char* ws = (unsigned char*)d_ws; const float* const* in = (const float* const*)d_in;
        bf16_t* P = (bf16_t*)(ws + WS_P); bf16_t* MIX = (bf16_t*)(ws + WS_MIX); bf16_t* VN = (bf16_t*)(ws + WS_MERGED); bf16_t* WSP = (bf16_t*)(ws + WS_WSP);
        k_vln<<<M / 4, 256, 0, stream>>>(P, in[10], in[11], VN);
        k_sgu<<<M * 2, 256, 0, stream>>>(P, VN, WSP, in[13], MIX);
        k_attn<<<BATCH * NCH * NQH, 128, 0, stream>>>(P, in[14], in[15], in[16], MIX);
    }
    a.ph_lo = 6; a.ph_hi = 10; a.li = 1;
    hipLaunchKernelGGL(mega_fwd, dim3(grid), dim3(NWAVES * 64), LDS_BYTES, stream, a);
#endif
}
```

```cpp
#include <hip/hip_runtime.h>
#include <cstdio>
#include <cstdint>
#include <cstring>
#ifndef N_LAUNCHES
#define N_LAUNCHES 1
#endif

typedef unsigned short bf16_t;
typedef short bf16x8 __attribute__((ext_vector_type(8)));
typedef float f32x4 __attribute__((ext_vector_type(4)));
typedef float f32x2 __attribute__((ext_vector_type(2)));
typedef unsigned u32x4 __attribute__((ext_vector_type(4)));
typedef unsigned u32x2 __attribute__((ext_vector_type(2)));
#define GAS __attribute__((address_space(1)))
#define LAS __attribute__((address_space(3)))
#define RLX_AGENT __ATOMIC_RELAXED, __HIP_MEMORY_SCOPE_AGENT
#define LDS_WAIT() asm volatile("s_waitcnt lgkmcnt(0)" ::: "memory")
#define VM_WAIT() asm volatile("s_waitcnt vmcnt(0)" ::: "memory")

__device__ __forceinline__ float bf2f(bf16_t h) { return __uint_as_float(((unsigned)h) << 16); }
__device__ __forceinline__ unsigned f2bf(float f) { unsigned u = __float_as_uint(f); return (u + 0x7fffu + ((u >> 16) & 1u)) >> 16; }
__device__ __forceinline__ unsigned pk2(float lo, float hi) { return f2bf(lo) | (f2bf(hi) << 16); }
__device__ __forceinline__ unsigned cvt_pk_bf16(float lo, float hi) { unsigned r; asm volatile("v_cvt_pk_bf16_f32 %0, %1, %2" : "=v"(r) : "v"(lo), "v"(hi)); return r; }
__device__ __forceinline__ float bflo(unsigned w) { return __uint_as_float(w << 16); }
__device__ __forceinline__ float bfhi(unsigned w) { return __uint_as_float(w & 0xffff0000u); }

constexpr int BATCH = 16, SEQ = 2048, D = 1024, M = BATCH * SEQ;
constexpr int FF = 2816, NGU = 2 * FF;
constexpr int DA = 512, DB = 512, NIN = 3840, NMOD = 9 * D;
constexpr int CHUNK = 128, NCH = SEQ / CHUNK, NG = 4, GD = 128;
constexpr int HD = 64, NQH = 8, NKVH = 2;
constexpr int PC_U = 0, PC_V = 512, PC_Q = 1024, PC_K = 1536, PC_VV = 1664, PC_GA = 1792, PC_GB = 2816;
constexpr float EPS = 1e-6f;
constexpr float LOG2E = 1.4426950408889634f;

constexpr size_t MiB = 1u << 20;
constexpr size_t WS_CTL = 0, CTL_BYTES = 64 * 1024;
constexpr int CW_BAR = 4096;
constexpr size_t WS_MODS = 1 * MiB;
constexpr size_t WS_CB1 = WS_MODS + 640 * 1024;
constexpr size_t WS_CB2 = WS_CB1 + 352 * 1024;
constexpr size_t WS_CB3 = WS_CB2 + 240 * 1024;
constexpr size_t WS_SS1 = WS_CB3 + 352 * 1024;
constexpr size_t WS_SS2 = WS_SS1 + 512 * 1024, WS_SS3 = WS_SS2 + 512 * 1024;
constexpr size_t WS_SMALL_END = WS_SS3 + 512 * 1024;
static_assert(WS_SMALL_END <= 5 * MiB, "small tables");
constexpr size_t WS_WGU1 = 5 * MiB;
constexpr size_t WS_WD1 = WS_WGU1 + (size_t)NGU * D * 2;
constexpr size_t WS_WIN = WS_WD1 + (size_t)D * FF * 2;
constexpr size_t WS_WA = WS_WIN + (size_t)NIN * D * 2;
constexpr size_t WS_WB = WS_WA + (size_t)D * DA * 2;
constexpr size_t WS_WO = WS_WB + (size_t)D * DB * 2;
constexpr size_t WS_WGU2 = WS_WO + (size_t)D * D * 2;
constexpr size_t WS_WD2 = WS_WGU2 + (size_t)NGU * D * 2;
constexpr size_t WS_WSP = WS_WD2 + (size_t)D * FF * 2;
constexpr size_t WS_W_END = WS_WSP + (size_t)NG * CHUNK * CHUNK * 2;
static_assert(WS_W_END <= 50 * MiB, "weights");
constexpr size_t WS_XN = 50 * MiB;
constexpr size_t WS_MIX = 50 * MiB;
constexpr size_t WS_H16 = 114 * MiB;
constexpr size_t WS_MERGED = 178 * MiB;
constexpr size_t WS_ACT = 242 * MiB;
constexpr size_t WS_P = 242 * MiB;
constexpr size_t WS_END = 482 * MiB;

#ifdef PROBE_STAMPS
#define STAMP(id) do { if (blockIdx.x == 0 && threadIdx.x == 0) ((unsigned long long*)(g_ws_ + WS_CTL))[40 + (id)] = __builtin_amdgcn_s_memrealtime(); } while (0)
#else
#define STAMP(id) do {} while (0)
#endif
__device__ __forceinline__ float fsigmoid(float v) { return __builtin_amdgcn_rcpf(1.0f + __builtin_amdgcn_exp2f(-LOG2E * v)); }
__device__ __forceinline__ float fgelu_tanh(float v) {
    const float u = 0.7978845608028654f * (v + 0.044715f * v * v * v);
    return v * fsigmoid(2.0f * u);
}

namespace pg8 {
constexpr int BM = 256, BK = 64, HALF = 128, HTB = HALF * BK * 2  , STAGE_BYTES = 8 * HTB, NXCD = 8, WGM = 8;

__host__ __device__ __forceinline__ int lds_byte(int r, int c) { const int st = (r >> 4) * 2 + (c >> 5), rr = r & 15, cc = c & 31, ob = rr * 64 + cc * 2; return st * 1024 + (ob ^ (((ob >> 9) & 1) << 5)); }
__host__ __device__ __forceinline__ void stage_rc(int b, int& R, int& C) { const int st = b / 1024, sb = b % 1024, swz = sb ^ (((sb >> 9) & 1) << 5); R = (st >> 1) * 16 + swz / 64; C = (st & 1) * 32 + (swz % 64) / 2; }
__host__ __device__ __forceinline__ int perm32(int rho) { const int n = rho >> 4, i = rho & 15; return 8 * (i >> 2) + 4 * n + (i & 3); }

struct Unit { int pm, pn, seg; };
struct Gemm { const bf16_t* A0; const bf16_t* A1; const bf16_t* B0; const bf16_t* B1; int lda, ldb, K; };

struct StaticOrder {
    int nM, nN, nwg, G, c, nseg, rev;
    __host__ __device__ void init(int M_, int N_, int G_, int c_, int nseg_ = 1, int rev_ = 0) { nM = M_ / BM; nN = N_ / BM; nwg = nM * nN; G = G_; c = c_; nseg = nseg_; rev = (rev_ && nwg % G_ == 0) ? nwg / G_ : 0; }
    __host__ __device__ bool next(int i, Unit& u) const {
        int ti = (nseg == 1) ? i : (i >> 1);
        if (rev) { if (ti >= rev) return false; ti = rev - 1 - ti; }
        const long L = (long)ti * G + c; if (L >= nwg) return false;
        int wgid = (int)L; { const int q = nwg / NXCD, r = nwg % NXCD, xcd = wgid % NXCD, off = wgid / NXCD; wgid = (xcd < r ? xcd * (q + 1) : r * (q + 1) + (xcd - r) * q) + off; }
        const int nig = WGM * nN, gid = wgid / nig, fm = gid * WGM, gsz = (nM - fm) < WGM ? (nM - fm) : WGM;
        u.pm = fm + ((wgid % nig) % gsz); u.pn = (wgid % nig) / gsz; u.seg = (nseg == 1) ? 0 : (i & 1); return true;
    }
};

template <class Epi, class Sched>
__device__ __forceinline__ void gemm_phase(LAS unsigned char* lds, const Gemm g, const Sched& S, const Epi& E, unsigned long long& epi_ticks) {
    const int tid = threadIdx.x, wid = __builtin_amdgcn_readfirstlane(tid >> 6), lane = tid & 63, wr = wid >> 2, wc = wid & 3, fr = lane & 15, fq = lane >> 4;
    const int nt = g.K / BK;
    unsigned voffA[2], voffB[2];
#pragma unroll
    for (int i = 0; i < 2; ++i) { int R, C; stage_rc(tid * 16 + i * 8192, R, C); const int Rb = Epi::MAPB ? ((R >> 5) * 64 + perm32(R & 31)) : ((R & ~31) + perm32(R & 31));
        voffA[i] = (unsigned)(R * g.lda + C) * 2u; voffB[i] = (unsigned)(Rb * g.ldb + C) * 2u; }
    const size_t kstep = (size_t)(BK * 2);
    const size_t hstepA = (size_t)HALF * g.lda * 2, hstepB = (size_t)HALF * g.ldb * 2;
    const size_t tstepA = 2 * hstepA, tstepB = 2 * hstepB;
    const size_t hoffB = Epi::MAPB ? (size_t)32 * g.ldb * 2 : hstepB;
    const unsigned ldsw = (unsigned)wid * 1024u;
    const int aoff = lds_byte(wr * 64 + fr, fq * 8), boff = lds_byte(wc * 32 + fr, fq * 8);
#define PG8_SA(b, h) (((b) * 2 + (h)) * HTB)
#define PG8_SB(b, h) ((4 + (b) * 2 + (h)) * HTB)
#define PG8_STAGE(bufoff, gbase, voff) do { _Pragma("unroll") for (int _i = 0; _i < 2; ++_i) \
        __builtin_amdgcn_global_load_lds((const unsigned*)((const char*)(gbase) + (voff)[_i]), (LAS unsigned*)(lds + (bufoff) + ldsw + _i * 8192), 16, 0, 0); } while (0)
#define PG8_LDA(dst, b, h) do { _Pragma("unroll") for (int m = 0; m < 4; ++m) _Pragma("unroll") for (int k = 0; k < 2; ++k) dst[m][k] = *(const LAS bf16x8*)(lds + PG8_SA(b, h) + aoff + m * 2048 + k * 1024); } while (0)
#define PG8_LDB(dst, b, h) do { _Pragma("unroll") for (int n = 0; n < 2; ++n) _Pragma("unroll") for (int k = 0; k < 2; ++k) dst[n][k] = *(const LAS bf16x8*)(lds + PG8_SB(b, h) + boff + n * 2048 + k * 1024); } while (0)
#define PG8_MMA(ai, bj, At, Bt) do { __builtin_amdgcn_s_setprio(1); _Pragma("unroll") for (int m = 0; m < 4; ++m) _Pragma("unroll") for (int n = 0; n < 2; ++n) _Pragma("unroll") for (int k = 0; k < 2; ++k) \
        acc[ai][bj][m][n] = __builtin_amdgcn_mfma_f32_16x16x32_bf16(Bt[n][k], At[m][k], acc[ai][bj][m][n], 0, 0, 0); __builtin_amdgcn_s_setprio(0); } while (0)
#define PG8_WAIT_V(n) asm volatile("s_waitcnt vmcnt(" #n ")" ::: "memory")
#define PG8_WAIT_L(n) asm volatile("s_waitcnt lgkmcnt(" #n ")" ::: "memory")
#define PG8_BAR __builtin_amdgcn_s_barrier()
#define PG8_SCHED __builtin_amdgcn_sched_barrier(0)
    Unit cur, nxt; int ui = 0;
    if (!S.next(0, cur)) return;
    f32x4 acc[2][2][4][2];
#pragma unroll
    for (int a = 0; a < 2; ++a)
#pragma unroll
        for (int b = 0; b < 2; ++b)
#pragma unroll
            for (int m = 0; m < 4; ++m)
#pragma unroll
                for (int n = 0; n < 2; ++n) acc[a][b][m][n] = (f32x4){0.f, 0.f, 0.f, 0.f};
    bf16x8 At[4][2], B0[2][2], B1[2][2];
    const char* cA = (const char*)(cur.seg ? g.A1 : g.A0) + (size_t)cur.pm * tstepA; const char* cB = (const char*)(cur.seg ? g.B1 : g.B0) + (size_t)cur.pn * tstepB;
    PG8_STAGE(PG8_SB(0, 0), cB, voffB); PG8_STAGE(PG8_SB(0, 1), cB + hoffB, voffB); PG8_STAGE(PG8_SA(0, 0), cA, voffA); PG8_STAGE(PG8_SA(0, 1), cA + hstepA, voffA);
    if (wr == 1) PG8_BAR;
    PG8_WAIT_V(2); PG8_BAR;
    PG8_STAGE(PG8_SB(1, 0), cB + kstep, voffB); PG8_STAGE(PG8_SA(1, 0), cA + kstep, voffA); PG8_STAGE(PG8_SB(1, 1), cB + hoffB + kstep, voffB);
    PG8_WAIT_V(6); PG8_BAR;
    for (;;) {
        const bool has_next = S.next(ui + 1, nxt);
        const char* nA = has_next ? (const char*)(nxt.seg ? g.A1 : g.A0) + (size_t)nxt.pm * tstepA : cA; const char* nB = has_next ? (const char*)(nxt.seg ? g.B1 : g.B0) + (size_t)nxt.pn * tstepB : cB;
#ifdef PROBE_KLOOP
        const unsigned long long tk0_ = __builtin_amdgcn_s_memrealtime();
#endif
        for (int t = 0; t < nt; t += 2) {
            const bool last = (t == nt - 2);
            const char* a1 = cA + (size_t)(t + 1) * kstep;
            const char* a2 = last ? nA : cA + (size_t)(t + 2) * kstep; const char* b2 = last ? nB : cB + (size_t)(t + 2) * kstep;
            const char* a3 = a2 + kstep; const char* b3 = b2 + kstep;
            PG8_LDB(B0, 0, 0); PG8_LDB(B1, 0, 1); PG8_SCHED; PG8_LDA(At, 0, 0); PG8_STAGE(PG8_SA(1, 1), a1 + hstepA, voffA);
            PG8_WAIT_V(8); PG8_WAIT_L(0); PG8_BAR; PG8_MMA(0, 0, At, B0); PG8_MMA(0, 1, At, B1); PG8_BAR; PG8_SCHED;
            PG8_LDA(At, 0, 1); PG8_STAGE(PG8_SB(0, 0), b2, voffB); PG8_STAGE(PG8_SB(0, 1), b2 + hoffB, voffB); PG8_STAGE(PG8_SA(0, 0), a2, voffA);
            PG8_WAIT_V(8); PG8_WAIT_L(0); PG8_BAR; PG8_MMA(1, 0, At, B0); PG8_MMA(1, 1, At, B1); PG8_BAR; PG8_SCHED;
            PG8_LDB(B0, 1, 0); PG8_LDB(B1, 1, 1); PG8_SCHED; PG8_LDA(At, 1, 0); PG8_STAGE(PG8_SA(0, 1), a2 + hstepA, voffA);
            PG8_WAIT_V(8); PG8_WAIT_L(0); PG8_BAR; PG8_MMA(0, 0, At, B0); PG8_MMA(0, 1, At, B1); PG8_BAR; PG8_SCHED;
            PG8_LDA(At, 1, 1); PG8_STAGE(PG8_SB(1, 0), b3, voffB); PG8_STAGE(PG8_SB(1, 1), b3 + hoffB, voffB); PG8_STAGE(PG8_SA(1, 0), a3, voffA);
            PG8_WAIT_V(8); PG8_WAIT_L(0); PG8_BAR; PG8_MMA(1, 0, At, B0); PG8_MMA(1, 1, At, B1); PG8_BAR; PG8_SCHED;
        }
#ifdef PROBE_KLOOP
        epi_ticks += __builtin_amdgcn_s_memrealtime() - tk0_;
#endif
        if (wr == 0) PG8_BAR;
#ifdef PROBE_LO
        const unsigned long long te0_ = __builtin_amdgcn_s_memrealtime();
#endif
        const bool keep = E(acc, cur, wr, wc, fr, fq);
#if defined(PROBE_LO) && !defined(PROBE_KLOOP)
        asm volatile("s_waitcnt vmcnt(0)" ::: "memory"); epi_ticks += __builtin_amdgcn_s_memrealtime() - te0_;
#endif
        if (!has_next) break;
        if (!keep) {
#pragma unroll
            for (int a = 0; a < 2; ++a)
#pragma unroll
                for (int b = 0; b < 2; ++b)
#pragma unroll
                    for (int m = 0; m < 4; ++m)
#pragma unroll
                        for (int n = 0; n < 2; ++n) acc[a][b][m][n] = (f32x4){0.f, 0.f, 0.f, 0.f};
        }
        cur = nxt; cA = nA; cB = nB; ++ui;
        if (wr == 1) PG8_BAR;
    }
    PG8_WAIT_V(0);
    PG8_BAR;
#undef PG8_SA
#undef PG8_SB
#undef PG8_STAGE
#undef PG8_LDA
#undef PG8_LDB
#undef PG8_MMA
#undef PG8_WAIT_V
#undef PG8_WAIT_L
#undef PG8_BAR
#undef PG8_SCHED
}
}

using pg8::Unit;
template <bool MAPB> __device__ __forceinline__ int colbase(const Unit& u, int bj, int wc, int fq) { return MAPB ? (u.pn * 256 + wc * 64 + bj * 32 + 8 * fq) : (u.pn * 256 + bj * 128 + wc * 32 + 8 * fq); }
__device__ __forceinline__ float rstd_of(const float* ss, int m) { const f32x4 p = *(const f32x4*)(ss + 4 * (size_t)m); return __builtin_amdgcn_rsqf(((p[0] + p[1]) + (p[2] + p[3])) * (1.0f / D) + EPS); }

template <bool RAW  > struct EpiGU {
    static constexpr bool MAPB = false;
    bf16_t* act; const float* ss; const float* cb;
    __device__ __forceinline__ bool operator()(f32x4 (&acc)[2][2][4][2], const Unit& u, int wr, int wc, int fr, int fq) const {
        const int b = u.pm >> 3;
        const float* cbp = cb + b * NGU + u.pn * 256 + wc * 32 + 8 * fq;
        f32x4 cg[2], cu[2];
        if constexpr (!RAW) {
#pragma unroll
            for (int n = 0; n < 2; ++n) { cg[n] = *(const f32x4*)(cbp + 4 * n); cu[n] = *(const f32x4*)(cbp + 128 + 4 * n); } }
#pragma unroll
        for (int ai = 0; ai < 2; ++ai)
#pragma unroll
            for (int m = 0; m < 4; ++m) {
                const int row = u.pm * 256 + ai * 128 + wr * 64 + m * 16 + fr; float rs = 1.0f; if constexpr (!RAW) rs = rstd_of(ss, row);
                unsigned w[4];
#pragma unroll
                for (int n = 0; n < 2; ++n) { f32x4 gv = acc[ai][0][m][n], uv = acc[ai][1][m][n]; if constexpr (!RAW) { gv = gv * rs + cg[n]; uv = uv * rs + cu[n]; } float o[4];
#pragma unroll
                    for (int i = 0; i < 4; ++i) o[i] = gv[i] * uv[i] * fsigmoid(gv[i]);
                    w[2 * n] = cvt_pk_bf16(o[0], o[1]); w[2 * n + 1] = cvt_pk_bf16(o[2], o[3]); }
                __builtin_nontemporal_store((u32x4){w[0], w[1], w[2], w[3]}, (u32x4*)(act + (size_t)row * FF + u.pn * 128 + wc * 32 + 8 * fq));
            }
        return false;
    }
};
typedef _Float16 f16x2 __attribute__((ext_vector_type(2)));
__device__ __forceinline__ unsigned pk_f16(float lo, float hi) { const f16x2 h = {(_Float16)lo, (_Float16)hi}; return __builtin_bit_cast(unsigned, h); }
__device__ __forceinline__ f32x2 unpk_f16(unsigned w) { const f16x2 h = __builtin_bit_cast(f16x2, w); return (f32x2){(float)h[0], (float)h[1]}; }
template <bool NORM, bool RIN16, bool ROUT16> struct EpiRes {
    static constexpr bool MAPB = true;
    const void* resid; void* hout; const float* ga; const float* gn; const float* sc; bf16_t* xn; float* ssq; LAS float* red; float gscale;
    __device__ __forceinline__ bool operator()(f32x4 (&acc)[2][2][4][2], const Unit& u, int wr, int wc, int fr, int fq) const {
        const int b = u.pm >> 3;
        f32x4 gav[2][2], gsv[2][2];
#pragma unroll
        for (int bj = 0; bj < 2; ++bj)
#pragma unroll
            for (int n = 0; n < 2; ++n) { const int c = colbase<MAPB>(u, bj, wc, fq) + 4 * n;
                gav[bj][n] = *(const f32x4*)(ga + b * NMOD + c) * gscale;
                if constexpr (NORM) gsv[bj][n] = *(const f32x4*)(gn + c) * (*(const f32x4*)(sc + b * NMOD + c) + 1.0f); }
#pragma unroll
        for (int ai = 0; ai < 2; ++ai)
#pragma unroll
            for (int m = 0; m < 4; ++m) {
                const int row = u.pm * 256 + ai * 128 + wr * 64 + m * 16 + fr; float s = 0.f;
#pragma unroll
                for (int bj = 0; bj < 2; ++bj) { const size_t off = (size_t)row * D + colbase<MAPB>(u, bj, wc, fq);
                    f32x4 r0, r1;
                    if constexpr (RIN16) { const u32x4 rw = *(const u32x4*)((const _Float16*)resid + off); const f32x2 q0 = unpk_f16(rw[0]), q1 = unpk_f16(rw[1]), q2 = unpk_f16(rw[2]), q3 = unpk_f16(rw[3]); r0 = (f32x4){q0[0], q0[1], q1[0], q1[1]}; r1 = (f32x4){q2[0], q2[1], q3[0], q3[1]}; }
                    else { r0 = *(const f32x4*)((const float*)resid + off); r1 = *(const f32x4*)((const float*)resid + off + 4); }
                    const f32x4 v0 = r0 + gav[bj][0] * acc[ai][bj][m][0], v1 = r1 + gav[bj][1] * acc[ai][bj][m][1];
                    if constexpr (ROUT16) *(u32x4*)((_Float16*)hout + off) = (u32x4){pk_f16(v0[0], v0[1]), pk_f16(v0[2], v0[3]), pk_f16(v1[0], v1[1]), pk_f16(v1[2], v1[3])};
                    else { __builtin_nontemporal_store(v0, (f32x4*)((float*)hout + off)); __builtin_nontemporal_store(v1, (f32x4*)((float*)hout + off + 4)); }
                    if constexpr (NORM) { const f32x4 a0 = v0 * gsv[bj][0], a1 = v1 * gsv[bj][1];
                        *(u32x4*)(xn + off) = (u32x4){cvt_pk_bf16(a0[0], a0[1]), cvt_pk_bf16(a0[2], a0[3]), cvt_pk_bf16(a1[0], a1[1]), cvt_pk_bf16(a1[2], a1[3])};
                        s += (v0[0] * v0[0] + v0[1] * v0[1]) + (v0[2] * v0[2] + v0[3] * v0[3]) + (v1[0] * v1[0] + v1[1] * v1[1]) + (v1[2] * v1[2] + v1[3] * v1[3]); } }
                if constexpr (NORM) { s += __shfl_xor(s, 16); s += __shfl_xor(s, 32); if (fq == 0) red[(ai * 128 + wr * 64 + m * 16 + fr) * 4 + wc] = s; }
                if (m == 3) asm volatile("" ::: "memory");
            }
        if constexpr (NORM) {
            asm volatile("s_waitcnt lgkmcnt(0)" ::: "memory"); __builtin_amdgcn_s_barrier(); asm volatile("" ::: "memory");
            const int tid = threadIdx.x;
            if (tid < 256) { const f32x4 p = *(const LAS f32x4*)(red + 4 * tid); ssq[(size_t)(u.pm * 256 + tid) * 4 + u.pn] = (p[0] + p[1]) + (p[2] + p[3]); }
        }
        return false;
    }
};
struct EpiWin {
    static constexpr bool MAPB = true;
    bf16_t* P; const float* ss; const float* cb;
    __device__ __forceinline__ bool operator()(f32x4 (&acc)[2][2][4][2], const Unit& u, int wr, int wc, int fr, int fq) const {
        const int b = u.pm >> 3; const int kind = u.pn < 4 ? 0 : (u.pn < 7 ? 1 : 2);
        f32x4 cv[2][2];
#pragma unroll
        for (int bj = 0; bj < 2; ++bj)
#pragma unroll
            for (int n = 0; n < 2; ++n) cv[bj][n] = *(const f32x4*)(cb + b * NIN + colbase<MAPB>(u, bj, wc, fq) + 4 * n);
#pragma unroll
        for (int ai = 0; ai < 2; ++ai)
#pragma unroll
            for (int m = 0; m < 4; ++m) {
                const int row = u.pm * 256 + ai * 128 + wr * 64 + m * 16 + fr; const float rs = rstd_of(ss, row);
#pragma unroll
                for (int bj = 0; bj < 2; ++bj) { unsigned w[4];
#pragma unroll
                    for (int n = 0; n < 2; ++n) { f32x4 v = acc[ai][bj][m][n] * rs + cv[bj][n];
                        if (kind == 0) { v[0] = fgelu_tanh(v[0]); v[1] = fgelu_tanh(v[1]); v[2] = fgelu_tanh(v[2]); v[3] = fgelu_tanh(v[3]); }
                        else if (kind == 2) { v[0] = fsigmoid(v[0]); v[1] = fsigmoid(v[1]); v[2] = fsigmoid(v[2]); v[3] = fsigmoid(v[3]); }
                        w[2 * n] = cvt_pk_bf16(v[0], v[1]); w[2 * n + 1] = cvt_pk_bf16(v[2], v[3]); }
                    __builtin_nontemporal_store((u32x4){w[0], w[1], w[2], w[3]}, (u32x4*)(P + (size_t)row * NIN + colbase<MAPB>(u, bj, wc, fq))); }
            }
        return false;
    }
};
struct EpiBranch {
    static constexpr bool MAPB = true;
    const bf16_t* P; bf16_t* merged;
    __device__ __forceinline__ bool operator()(f32x4 (&acc)[2][2][4][2], const Unit& u, int wr, int wc, int fr, int fq) const {
#pragma unroll
        for (int ai = 0; ai < 2; ++ai)
#pragma unroll
            for (int m = 0; m < 4; ++m) {
                const int row = u.pm * 256 + ai * 128 + wr * 64 + m * 16 + fr;
#pragma unroll
                for (int bj = 0; bj < 2; ++bj) { const int c = colbase<MAPB>(u, bj, wc, fq);
                    const u32x4 gb = *(const u32x4*)(P + (size_t)row * NIN + PC_GB + c);
                    float sb[8] = {bflo(gb[0]), bfhi(gb[0]), bflo(gb[1]), bfhi(gb[1]), bflo(gb[2]), bfhi(gb[2]), bflo(gb[3]), bfhi(gb[3])};
                    if (u.seg == 0) {
                        const u32x4 gaw = *(const u32x4*)(P + (size_t)row * NIN + PC_GA + c);
                        const float sa[8] = {bflo(gaw[0]), bfhi(gaw[0]), bflo(gaw[1]), bfhi(gaw[1]), bflo(gaw[2]), bfhi(gaw[2]), bflo(gaw[3]), bfhi(gaw[3])};
#pragma unroll
                        for (int i = 0; i < 4; ++i) { acc[ai][bj][m][0][i] *= sa[i] * __builtin_amdgcn_rcpf(fmaxf(sb[i], 1e-30f)); acc[ai][bj][m][1][i] *= sa[4 + i] * __builtin_amdgcn_rcpf(fmaxf(sb[4 + i], 1e-30f)); }
                    } else {
                        const f32x4 a0 = acc[ai][bj][m][0], a1 = acc[ai][bj][m][1];
                        *(u32x4*)(merged + (size_t)row * D + c) = (u32x4){cvt_pk_bf16(a0[0] * sb[0], a0[1] * sb[1]), cvt_pk_bf16(a0[2] * sb[2], a0[3] * sb[3]), cvt_pk_bf16(a1[0] * sb[4], a1[1] * sb[5]), cvt_pk_bf16(a1[2] * sb[6], a1[3] * sb[7])};
                    } }
                if (m == 3) asm volatile("" ::: "memory");
            }
        return u.seg == 0;
    }
};

#define XB_TMO      128
#define XB_XCNT(j)  (256  + 64 * (j))
#define XB_XSUB(j)  (1280 + 64 * (j))
#define XB_XGEN(j)  (2304 + 64 * (j))
#define XB_TOP      3328
#define XB_TOPGEN   3392
#define XCD_BAR_WORDS 3456
#define XB_SPIN_CAP (1u << 18)

__device__ __forceinline__ unsigned xb_ld(unsigned* p)              { return __hip_atomic_load(p, __ATOMIC_RELAXED, __HIP_MEMORY_SCOPE_AGENT); }
__device__ __forceinline__ unsigned xb_add(unsigned* p, unsigned v) { return __hip_atomic_fetch_add(p, v, __ATOMIC_RELAXED, __HIP_MEMORY_SCOPE_AGENT); }
__device__ __forceinline__ unsigned xb_xcc_id() { return (unsigned)__builtin_amdgcn_s_getreg((3 << 11) | 20) & 0xFu; }
#define XB_SPIN(cond, bar) do { unsigned _sp = 0; while (cond) { __builtin_amdgcn_s_sleep(1); \
    if ((++_sp & 255u) == 0u) { if (xb_ld(&(bar)[XB_TMO])) break; if (_sp > XB_SPIN_CAP) { atomicAdd(&(bar)[XB_TMO], 1u); break; } } } } while (0)

struct XcdBarrier {
    unsigned* bar; unsigned x;
    volatile LAS unsigned* st;
};

__device__ __forceinline__ XcdBarrier xcd_barrier_post(unsigned* bar, volatile LAS unsigned* st) {
    XcdBarrier b; b.bar = bar; b.x = xb_xcc_id(); b.st = st;
    if (threadIdx.x == 0) (void)xb_add(&bar[XB_XCNT(b.x)], 1u);
    return b;
}
__device__ __forceinline__ void xcd_barrier_complete(unsigned* bar, unsigned x, unsigned& nloc, unsigned& nx) {
    const unsigned G = gridDim.x * gridDim.y * gridDim.z;
    unsigned sum, cnt, mine, sp = 0u;
    for (;;) {
        sum = 0u; cnt = 0u; mine = 0u;
#pragma unroll
        for (unsigned j = 0; j < 16; ++j) { const unsigned c = xb_ld(&bar[XB_XCNT(j)]); sum += c; cnt += (c > 0u) ? 1u : 0u; mine = (j == x) ? c : mine; }
        if (sum == G) break;
        __builtin_amdgcn_s_sleep(1);
        if ((++sp & 255u) == 0u) { if (xb_ld(&bar[XB_TMO])) break; if (sp > XB_SPIN_CAP) { atomicAdd(&bar[XB_TMO], 1u); break; } }
    }
    nloc = mine > 0u ? mine : 1u; nx = cnt > 0u ? cnt : 1u;
}

__device__ __forceinline__ void xcd_barrier(const XcdBarrier& b) {
    asm volatile("s_waitcnt vmcnt(0)" ::: "memory");
    __syncthreads();
    if (threadIdx.x == 0) {
        unsigned* bar = b.bar;
        __builtin_amdgcn_s_waitcnt(0);
        unsigned nloc = b.st[0], nx = b.st[1];
        if (nloc == 0u) { xcd_barrier_complete(bar, b.x, nloc, nx); b.st[0] = nloc; b.st[1] = nx; }
        const unsigned old = xb_add(&bar[XB_XSUB(b.x)], 1u);
        const unsigned gen = old / nloc;
        if (old + 1u == (gen + 1u) * nloc) {
            __builtin_amdgcn_fence(__ATOMIC_RELEASE, "agent");
            asm volatile("s_waitcnt vmcnt(0)" ::: "memory");
            const unsigned og = xb_add(&bar[XB_TOP], 1u);
            const unsigned tg = og / nx;
            if (og + 1u == (tg + 1u) * nx) xb_add(&bar[XB_TOPGEN], 1u);
            else XB_SPIN(xb_ld(&bar[XB_TOPGEN]) == tg, bar);
            __builtin_amdgcn_fence(__ATOMIC_ACQUIRE, "agent");
            xb_add(&bar[XB_XGEN(b.x)], 1u);
            asm volatile("s_waitcnt vmcnt(0)" ::: "memory");
        } else {
            XB_SPIN(xb_ld(&bar[XB_XGEN(b.x)]) == gen, bar);
            __builtin_amdgcn_fence(__ATOMIC_ACQUIRE, "agent");
            asm volatile("s_waitcnt vmcnt(0)" ::: "memory");
        }
    }
    __syncthreads();
}

constexpr int NWAVES = 8;
constexpr int RING_OFF = 0, RING_BYTES = 131072;
constexpr int LDSCTL_OFF = RING_BYTES, MISC_OFF = LDSCTL_OFF + 320, RED_OFF = LDSCTL_OFF + 4096;
constexpr int LDS_BYTES = 147456;
static_assert(MISC_OFF + 128 <= RED_OFF && RED_OFF + 4096 <= LDS_BYTES, "LDS map");

struct Frame {
    LAS unsigned char* lds;
    volatile LAS unsigned* MISC;
    int tid, lane, wave;
    int vcu, G;
};
struct Args { const float* in[24]; float* out; unsigned char* ws; int ph_lo, ph_hi, li, pad; };

__device__ __forceinline__ float wave_sum(float v) {
#pragma unroll
    for (int o = 1; o < 64; o <<= 1) v += __shfl_xor(v, o);
    return v;
}
__device__ __forceinline__ void p0_mods_item(const Frame& F, const float* c, const float* w_ada, const float* b_ada, float* mods, int item, bool fill) {
    LAS float* sc = (LAS float*)(F.lds + RING_OFF);
    LAS float* red = (LAS float*)(F.lds + RING_OFF + 65536);
    if (fill) { for (int i = F.tid; i < BATCH * D; i += NWAVES * 64) { const float v = c[i]; sc[i] = v * fsigmoid(v); } __syncthreads(); }
    const int j = item * 64 + F.lane, k0 = F.wave * 128;
    float acc[BATCH];
#pragma unroll
    for (int b = 0; b < BATCH; ++b) acc[b] = 0.f;
#pragma unroll 2
    for (int kb = 0; kb < 128; kb += 16) {
        float wv[16];
#pragma unroll
        for (int i = 0; i < 16; ++i) wv[i] = w_ada[(size_t)(k0 + kb + i) * NMOD + j];
#pragma unroll
        for (int q = 0; q < 4; ++q)
#pragma unroll
            for (int b = 0; b < BATCH; ++b) { const f32x4 s4 = *(const LAS f32x4*)(sc + b * D + k0 + kb + 4 * q);
                acc[b] += s4[0] * wv[4 * q] + s4[1] * wv[4 * q + 1] + s4[2] * wv[4 * q + 2] + s4[3] * wv[4 * q + 3]; }
    }
#pragma unroll
    for (int b = 0; b < BATCH; ++b) red[(F.wave * BATCH + b) * 64 + F.lane] = acc[b];
    __syncthreads();
    for (int i = F.tid; i < BATCH * 64; i += NWAVES * 64) { const int b = i >> 6, l = i & 63; float s = 0.f;
#pragma unroll
        for (int w = 0; w < NWAVES; ++w) s += red[(w * BATCH + b) * 64 + l];
        mods[b * NMOD + item * 64 + l] = s + b_ada[item * 64 + l]; }
    __syncthreads();
}
__device__ __forceinline__ void p0_transpose_item(const float* W, int K, int N, bf16_t* WT, int gu, LAS float* scr, int item, int lane) {
    const int nblk = N / 32, kb = item / nblk, nb = item % nblk, k0 = 64 * kb, n0 = 32 * nb;
    {
        const int kk = lane >> 3, nq = lane & 7; f32x4 v[8];
#pragma unroll
        for (int i = 0; i < 8; ++i) v[i] = *(const f32x4*)(W + (size_t)(k0 + 8 * i + kk) * N + n0 + 4 * nq);
#pragma unroll
        for (int i = 0; i < 8; ++i) { LAS float* d = scr + (8 * i + kk) * 33 + 4 * nq; d[0] = v[i][0]; d[1] = v[i][1]; d[2] = v[i][2]; d[3] = v[i][3]; }
    }
    LDS_WAIT(); asm volatile("" ::: "memory");
    const int c = lane & 7;
    const int r0 = gu ? (256 * (n0 >> 7) + (n0 & 127) + 128 * (gu - 1)) : n0;
#pragma unroll
    for (int j = 0; j < 4; ++j) { const int n = (lane >> 3) + 8 * j; const LAS float* s = scr + (8 * c) * 33 + n;
        u32x4 o; o.x = pk2(s[0 * 33], s[1 * 33]); o.y = pk2(s[2 * 33], s[3 * 33]); o.z = pk2(s[4 * 33], s[5 * 33]); o.w = pk2(s[6 * 33], s[7 * 33]);
        *(GAS u32x4*)(WT + (size_t)(r0 + n) * K + k0 + 8 * c) = o; }
    LDS_WAIT(); asm volatile("" ::: "memory");
}
struct WsPtrs {
    float *mods, *cb1, *cb2, *cb3, *ss1, *ss2, *ss3;
    bf16_t *WGU1, *WD1, *WIN, *WA, *WB, *WO, *WGU2, *WD2, *WSP, *XN, *MIX, *MERGED, *ACT, *P; _Float16* H16;
};
__device__ __forceinline__ void late_conversions(const Frame& F, const Args& a, const WsPtrs& w, int widx, int NW) {
    LAS float* scr = (LAS float*)(F.lds + RING_OFF + F.wave * 16384);
    constexpr int I_G = (D / 64) * (FF / 32), I_D = (FF / 64) * (D / 32);
    for (int it = widx; it < 2 * I_G + I_D; it += NW) {
        int r = it;
        if (r < I_G) { p0_transpose_item(a.in[21], D, FF, w.WGU2, 1, scr, r, F.lane); continue; } r -= I_G;
        if (r < I_G) { p0_transpose_item(a.in[22], D, FF, w.WGU2, 2, scr, r, F.lane); continue; } r -= I_G;
        p0_transpose_item(a.in[23], FF, D, w.WD2, 0, scr, r, F.lane);
    }
}
__device__ __forceinline__ void xpass(const Frame& F, const Args& a, const WsPtrs& w);
constexpr int CW_MODS_DONE = 128;
__device__ __forceinline__ void p0_prologue(const Frame& F, const Args& a, const WsPtrs& w) {
    if (F.vcu < NMOD / 64) p0_mods_item(F, a.in[1], a.in[2], a.in[3], w.mods, F.vcu, true);
    LAS float* scr = (LAS float*)(F.lds + RING_OFF + F.wave * 16384);
    const int gw = F.vcu * NWAVES + F.wave, NGW = F.G * NWAVES;
    constexpr int I_G = (D / 64) * (FF / 32), I_D = (FF / 64) * (D / 32), I_IN = (D / 64) * (NIN / 32), I_AB = (DA / 64) * (D / 32), I_O = (D / 64) * (D / 32);
    constexpr int NITEMS = 4 * I_G + 2 * I_D + I_IN + 2 * I_AB + I_O;
    constexpr int NMODCU = NMOD / 64, R0 = 4;
    const bool balanced = (F.G == 256);
    const int nfree = (F.G - NMODCU) * NWAVES, early = balanced ? R0 * nfree : 0;
    for (int rho = 0;; ++rho) {
        int it;
        if (!balanced) it = rho * NGW + gw;
        else if (rho < R0) { if (F.vcu < NMODCU) continue; it = rho * nfree + (F.vcu - NMODCU) * NWAVES + F.wave; }
        else it = early + (rho - R0) * NGW + gw;
        if (it >= NITEMS) break;
        int r = it;
        if (r < I_G) { p0_transpose_item(a.in[5], D, FF, w.WGU1, 1, scr, r, F.lane); continue; } r -= I_G;
        if (r < I_G) { p0_transpose_item(a.in[6], D, FF, w.WGU1, 2, scr, r, F.lane); continue; } r -= I_G;
        if (r < I_D) { p0_transpose_item(a.in[7], FF, D, w.WD1, 0, scr, r, F.lane); continue; } r -= I_D;
        if (r < I_IN) { p0_transpose_item(a.in[9], D, NIN, w.WIN, 0, scr, r, F.lane); continue; } r -= I_IN;
        if (r < I_AB) { p0_transpose_item(a.in[17], DA, D, w.WA, 0, scr, r, F.lane); continue; } r -= I_AB;
        if (r < I_AB) { p0_transpose_item(a.in[18], DB, D, w.WB, 0, scr, r, F.lane); continue; } r -= I_AB;
        if (r < I_O) { p0_transpose_item(a.in[19], D, D, w.WO, 0, scr, r, F.lane); continue; } r -= I_O;
        if (r < I_G) { p0_transpose_item(a.in[21], D, FF, w.WGU2, 1, scr, r, F.lane); continue; } r -= I_G;
        if (r < I_G) { p0_transpose_item(a.in[22], D, FF, w.WGU2, 2, scr, r, F.lane); continue; } r -= I_G;
        p0_transpose_item(a.in[23], FF, D, w.WD2, 0, scr, r, F.lane);
    }
    for (int i = (F.vcu * NWAVES * 64 + F.tid); i < NG * CHUNK * CHUNK; i += F.G * NWAVES * 64) { const int s = i & 127, t = (i >> 7) & 127; w.WSP[i] = (bf16_t)f2bf(s <= t ? a.in[12][i] : 0.f); }
}
__device__ __forceinline__ void p1_cb_item(const Frame& F, const float* sh  , const bf16_t* Wt, int N, float* cb, int item) {
    const int r = F.lane & 15, g = F.lane >> 4, R0 = item * 16;
    const bf16_t* wp = Wt + (size_t)(R0 + r) * D + 8 * g; const float* sp = sh + r * NMOD + 8 * g;
    f32x4 acc = (f32x4){0.f, 0.f, 0.f, 0.f};
#pragma unroll 16
    for (int ks = 0; ks < D / 32; ++ks) {
        const bf16x8 wa = *(const bf16x8*)(wp + 32 * ks);
        const f32x4 s0 = *(const f32x4*)(sp + 32 * ks), s1 = *(const f32x4*)(sp + 32 * ks + 4);
        const float sv[8] = {s0[0], s0[1], s0[2], s0[3], s1[0], s1[1], s1[2], s1[3]};
        unsigned hi[4], lo[4];
#pragma unroll
        for (int i = 0; i < 4; ++i) { const unsigned h0 = f2bf(sv[2 * i]), h1 = f2bf(sv[2 * i + 1]); hi[i] = h0 | (h1 << 16);
            lo[i] = f2bf(sv[2 * i] - __uint_as_float(h0 << 16)) | (f2bf(sv[2 * i + 1] - __uint_as_float(h1 << 16)) << 16); }
        acc = __builtin_amdgcn_mfma_f32_16x16x32_bf16(wa, __builtin_bit_cast(bf16x8, (u32x4){hi[0], hi[1], hi[2], hi[3]}), acc, 0, 0, 0);
        acc = __builtin_amdgcn_mfma_f32_16x16x32_bf16(wa, __builtin_bit_cast(bf16x8, (u32x4){lo[0], lo[1], lo[2], lo[3]}), acc, 0, 0, 0);
    }
    *(f32x4*)(cb + (size_t)r * N + R0 + 4 * g) = acc;
}
__device__ __forceinline__ void xpass(const Frame& F, const Args& a, const WsPtrs& w) {
    const int gw = F.vcu * NWAVES + F.wave, NGW = F.G * NWAVES;
    for (int blk = gw; blk < M / 16; blk += NGW) {
        const int m0 = blk * 16, b = m0 >> 11;
        f32x4 gsv[2][2], shv[2][2];
#pragma unroll
        for (int j = 0; j < 2; ++j)
#pragma unroll
            for (int h = 0; h < 2; ++h) { const int k = j * 512 + F.lane * 8 + h * 4; gsv[j][h] = *(const f32x4*)(a.in[4] + k) * (*(const f32x4*)(w.mods + b * NMOD + 1 * D + k) + 1.0f); shv[j][h] = *(const f32x4*)(w.mods + b * NMOD + k); }
        for (int r4 = 0; r4 < 16; r4 += 4) {
            f32x4 v[4][2][2];
#pragma unroll
            for (int r = 0; r < 4; ++r)
#pragma unroll
                for (int j = 0; j < 2; ++j) { const float* xr = a.in[0] + (size_t)(m0 + r4 + r) * D + j * 512 + F.lane * 8; v[r][j][0] = *(const f32x4*)xr; v[r][j][1] = *(const f32x4*)(xr + 4); }
#pragma unroll
            for (int r = 0; r < 4; ++r) { float s = 0.f;
#pragma unroll
                for (int j = 0; j < 2; ++j) { const f32x4 v0 = v[r][j][0], v1 = v[r][j][1];
                    s += (v0[0] * v0[0] + v0[1] * v0[1]) + (v0[2] * v0[2] + v0[3] * v0[3]) + (v1[0] * v1[0] + v1[1] * v1[1]) + (v1[2] * v1[2] + v1[3] * v1[3]); }
                s = wave_sum(s); const float rs = __builtin_amdgcn_rsqf(s * (1.0f / D) + EPS);
#pragma unroll
                for (int j = 0; j < 2; ++j) { const f32x4 a0 = v[r][j][0] * rs * gsv[j][0] + shv[j][0], a1 = v[r][j][1] * rs * gsv[j][1] + shv[j][1];
                    *(u32x4*)(w.XN + (size_t)(m0 + r4 + r) * D + j * 512 + F.lane * 8) = (u32x4){cvt_pk_bf16(a0[0], a0[1]), cvt_pk_bf16(a0[2], a0[3]), cvt_pk_bf16(a1[0], a1[1]), cvt_pk_bf16(a1[2], a1[3])}; } }
        }
    }
}
__device__ __forceinline__ void p1_phase(const Frame& F, const Args& a, const WsPtrs& w) {
    xpass(F, a, w);
    const int gw = F.vcu * NWAVES + F.wave, NGW = F.G * NWAVES;
    constexpr int I1 = NGU / 16, I2 = NIN / 16;
    for (int it = gw; it < I1 + I2; it += NGW) {
        if (it < I2) p1_cb_item(F, w.mods + 3 * D, w.WIN, NIN, w.cb2, it);
        else p1_cb_item(F, w.mods + 6 * D, w.WGU2, NGU, w.cb3, it - I2);
    }
}
__device__ __forceinline__ void cb3_items(const Frame& F, const WsPtrs& w) {
    const int gw = F.vcu * NWAVES + F.wave, NGW = F.G * NWAVES;
    for (int it = gw; it < NGU / 16; it += NGW) p1_cb_item(F, w.mods + 6 * D, w.WGU2, NGU, w.cb3, it);
}

__global__ void k_vln(const bf16_t* P, const float* g, const float* bta, bf16_t* vn) {
    const int m = (blockIdx.x * blockDim.x + threadIdx.x) >> 6, lane = threadIdx.x & 63;
    if (m >= M) return;
    float v[8], s = 0.f;
    for (int i = 0; i < 8; ++i) { v[i] = bf2f(P[(size_t)m * NIN + PC_V + i * 64 + lane]); s += v[i]; }
    for (int o = 1; o < 64; o <<= 1) s += __shfl_xor(s, o);
    const float mu = s * (1.0f / DA); float q = 0.f;
    for (int i = 0; i < 8; ++i) { v[i] -= mu; q += v[i] * v[i]; }
    for (int o = 1; o < 64; o <<= 1) q += __shfl_xor(q, o);
    const float rs = rsqrtf(q * (1.0f / DA) + EPS);
    for (int i = 0; i < 8; ++i) { const int c = i * 64 + lane; vn[(size_t)m * DA + c] = f2bf(v[i] * rs * g[c] + bta[c]); }
}
__global__ void k_sgu(const bf16_t* P, const bf16_t* vn, const bf16_t* wsp, const float* bsp, bf16_t* mix) {
    const int ch = threadIdx.x + (blockIdx.x & 1) * 256, m = blockIdx.x >> 1;
    const int t = m & 127, g = ch >> 7, m0 = m - t;
    float z = 0.f;
    for (int s = 0; s <= t; ++s) z += bf2f(wsp[(g * 128 + t) * 128 + s]) * bf2f(vn[(size_t)(m0 + s) * DA + ch]);
    z += bsp[g * 128 + t];
    mix[(size_t)m * D + ch] = f2bf(bf2f(P[(size_t)m * NIN + PC_U + ch]) * z);
}
__global__ __launch_bounds__(128) void k_attn(const bf16_t* P, const float* gq, const float* gk, const float* sinks, bf16_t* mix) {
    const int i = threadIdx.x, hq = blockIdx.x & 7, n = (blockIdx.x >> 3) & 15, b = blockIdx.x >> 7, h = hq >> 2;
    const int m = b * SEQ + n * 128 + i;
    float q[64], o[64]; float s2 = 0.f;
    for (int d = 0; d < 64; ++d) { q[d] = bf2f(P[(size_t)m * NIN + PC_Q + hq * 64 + d]); s2 += q[d] * q[d]; o[d] = 0.f; }
    const float qs = rsqrtf(s2 * (1.0f / 64) + EPS) * 0.125f;
    for (int d = 0; d < 64; ++d) q[d] *= qs * gq[d];
    const float sink = sinks[hq];
    float mx = sink, l = 1.0f;
    for (int dj = 127; dj >= 0; --dj) {
        const int kp = n * 128 + i - dj; if (kp < 0) continue;
        const bf16_t* kr = P + (size_t)(b * SEQ + kp) * NIN + PC_K + h * 64;
        float kk[64], k2 = 0.f;
        for (int d = 0; d < 64; ++d) { kk[d] = bf2f(kr[d]); k2 += kk[d] * kk[d]; }
        const float ks = rsqrtf(k2 * (1.0f / 64) + EPS); float sc = 0.f;
        for (int d = 0; d < 64; ++d) sc += q[d] * kk[d] * gk[d];
        sc *= ks;
        const float nm = fmaxf(mx, sc), f = __expf(mx - nm), p = __expf(sc - nm);
        const bf16_t* vr = P + (size_t)(b * SEQ + kp) * NIN + PC_VV + h * 64;
        for (int d = 0; d < 64; ++d) o[d] = o[d] * f + p * bf2f(vr[d]);
        l = l * f + p; mx = nm;
    }
    const float il = 1.0f / l;
    for (int d = 0; d < 64; ++d) mix[(size_t)m * D + 512 + hq * 64 + d] = f2bf(o[d] * il);
}


typedef short s16x4 __attribute__((ext_vector_type(4)));
typedef short v4i16_t __attribute__((ext_vector_type(4)));
__device__ __forceinline__ s16x4 vtr(const LAS unsigned char* p) { return __builtin_bit_cast(s16x4, __builtin_amdgcn_ds_read_tr16_b64_v4i16((LAS v4i16_t*)p)); }
__device__ __forceinline__ bf16x8 cat4(s16x4 a, s16x4 b) { return (bf16x8){a[0], a[1], a[2], a[3], b[0], b[1], b[2], b[3]}; }
__device__ __forceinline__ void unpack8(const u32x4 v, float (&f)[8]) { f[0] = bflo(v[0]); f[1] = bfhi(v[0]); f[2] = bflo(v[1]); f[3] = bfhi(v[1]); f[4] = bflo(v[2]); f[5] = bfhi(v[2]); f[6] = bflo(v[3]); f[7] = bfhi(v[3]); }

constexpr int ATT_K_OFF = 0, ATT_V_OFF = 32768;
static_assert(4 * 128 * 256 <= RING_BYTES, "mixer LDS");

struct KVRaw { u32x4 k[4], v[4]; };
__device__ __forceinline__ void attn_load_kv(KVRaw& r, const Frame& F, const bf16_t* P, int b, int n, int h) {
    const int ch = F.tid & 7;
#pragma unroll
    for (int it = 0; it < 4; ++it) {
        const int j = (F.tid >> 3) + 64 * it, kp = (n - 1) * 128 + j;
        r.k[it] = (u32x4){0u, 0u, 0u, 0u}; r.v[it] = (u32x4){0u, 0u, 0u, 0u};
        if (kp >= 0) { const bf16_t* rowp = P + (size_t)(b * SEQ + kp) * NIN; r.k[it] = *(const u32x4*)(rowp + PC_K + h * 64 + ch * 8); r.v[it] = *(const u32x4*)(rowp + PC_VV + h * 64 + ch * 8); }
    }
}
__device__ __forceinline__ void attn_unit(const Frame& F, const bf16_t* P, bf16_t* MIX, const float* gq, const float* gk, const float* sinks, int b, int n, int h, KVRaw& raw, bool has_next, int nb, int nn, int nh) {
    const int lane = F.lane, w = F.wave, r = lane & 15, g = lane >> 4;
    LAS unsigned char* Kt = F.lds + RING_OFF + ATT_K_OFF; LAS unsigned char* Vt = F.lds + RING_OFF + ATT_V_OFF;
    const int qrow = b * SEQ + n * 128 + 16 * w + r;
    u32x4 qraw[4][2];
#pragma unroll
    for (int hh = 0; hh < 4; ++hh) { const bf16_t* qp = P + (size_t)qrow * NIN + PC_Q + (4 * h + hh) * 64; qraw[hh][0] = *(const u32x4*)(qp + 8 * g); qraw[hh][1] = *(const u32x4*)(qp + 32 + 8 * g); }
    {
        const int ch = F.tid & 7;
        const f32x4 gk0 = *(const f32x4*)(gk + ch * 8), gk1 = *(const f32x4*)(gk + ch * 8 + 4);
#pragma unroll
        for (int it = 0; it < 4; ++it) {
            const int j = (F.tid >> 3) + 64 * it;
            float kf[8]; unpack8(raw.k[it], kf);
            float ss = (kf[0] * kf[0] + kf[1] * kf[1]) + (kf[2] * kf[2] + kf[3] * kf[3]) + (kf[4] * kf[4] + kf[5] * kf[5]) + (kf[6] * kf[6] + kf[7] * kf[7]);
            ss += __shfl_xor(ss, 1); ss += __shfl_xor(ss, 2); ss += __shfl_xor(ss, 4);
            const float rs = __builtin_amdgcn_rsqf(ss * (1.0f / HD) + EPS);
            const u32x4 kn = (u32x4){cvt_pk_bf16(kf[0] * rs * gk0[0], kf[1] * rs * gk0[1]), cvt_pk_bf16(kf[2] * rs * gk0[2], kf[3] * rs * gk0[3]),
                                     cvt_pk_bf16(kf[4] * rs * gk1[0], kf[5] * rs * gk1[1]), cvt_pk_bf16(kf[6] * rs * gk1[2], kf[7] * rs * gk1[3])};
            *(LAS u32x4*)(Kt + j * 128 + 16 * (ch ^ (j & 7))) = kn;
            const int x = (j >> 1) & 3; const u32x4 vv = raw.v[it];
            *(LAS u32x4*)(Vt + j * 128 + 16 * (ch ^ (x >> 1))) = (x & 1) ? (u32x4){vv[2], vv[3], vv[0], vv[1]} : vv;
        }
    }
    __syncthreads();
    if (has_next) attn_load_kv(raw, F, P, nb, nn, nh);
    const int q4 = (lane & 15) >> 2, p4 = lane & 3;
    const int vx = (2 * g + (q4 >> 1)) & 3;
#pragma unroll
    for (int hh = 0; hh < 4; ++hh) {
        const int hq = 4 * h + hh;
        bf16x8 qa0, qa1;
        {
            float a[8], c[8]; unpack8(qraw[hh][0], a); unpack8(qraw[hh][1], c);
            float ss = 0.f;
#pragma unroll
            for (int i = 0; i < 8; ++i) ss += a[i] * a[i] + c[i] * c[i];
            ss += __shfl_xor(ss, 16); ss += __shfl_xor(ss, 32);
            const float qs = __builtin_amdgcn_rsqf(ss * (1.0f / HD) + EPS) * (0.125f * LOG2E);
            const f32x4 ga0 = *(const f32x4*)(gq + 8 * g), ga1 = *(const f32x4*)(gq + 8 * g + 4), gc0 = *(const f32x4*)(gq + 32 + 8 * g), gc1 = *(const f32x4*)(gq + 32 + 8 * g + 4);
            const u32x4 p0 = (u32x4){cvt_pk_bf16(a[0] * qs * ga0[0], a[1] * qs * ga0[1]), cvt_pk_bf16(a[2] * qs * ga0[2], a[3] * qs * ga0[3]), cvt_pk_bf16(a[4] * qs * ga1[0], a[5] * qs * ga1[1]), cvt_pk_bf16(a[6] * qs * ga1[2], a[7] * qs * ga1[3])};
            const u32x4 p1 = (u32x4){cvt_pk_bf16(c[0] * qs * gc0[0], c[1] * qs * gc0[1]), cvt_pk_bf16(c[2] * qs * gc0[2], c[3] * qs * gc0[3]), cvt_pk_bf16(c[4] * qs * gc1[0], c[5] * qs * gc1[1]), cvt_pk_bf16(c[6] * qs * gc1[2], c[7] * qs * gc1[3])};
            qa0 = __builtin_bit_cast(bf16x8, p0); qa1 = __builtin_bit_cast(bf16x8, p1);
        }
        f32x4 sacc[10];
#pragma unroll
        for (int fp = 0; fp < 9; ++fp) {
            const int f = (w + fp) < 16 ? (w + fp) : 15; const LAS unsigned char* kr = Kt + (16 * f + r) * 128;
            const bf16x8 k0 = *(const LAS bf16x8*)(kr + 16 * (g ^ (r & 7))), k1 = *(const LAS bf16x8*)(kr + 16 * ((4 + g) ^ (r & 7)));
            sacc[fp] = __builtin_amdgcn_mfma_f32_16x16x32_bf16(k0, qa0, (f32x4){0.f, 0.f, 0.f, 0.f}, 0, 0, 0);
            sacc[fp] = __builtin_amdgcn_mfma_f32_16x16x32_bf16(k1, qa1, sacc[fp], 0, 0, 0);
        }
        const float sink2 = sinks[hq] * LOG2E;
        float mx = sink2;
#pragma unroll
        for (int fp = 0; fp < 9; ++fp) {
            const bool fvalid = (n > 0) || (w + fp >= 8);
#pragma unroll
            for (int e = 0; e < 4; ++e) { const int rel = 16 * fp + 4 * g + e - r;
                const bool valid = fvalid && (fp == 0 ? (rel >= 1) : (fp == 8 ? (rel <= 128) : true));
                const float t = valid ? sacc[fp][e] : -INFINITY; sacc[fp][e] = t; mx = fmaxf(mx, t); } }
        mx = fmaxf(mx, __shfl_xor(mx, 16)); mx = fmaxf(mx, __shfl_xor(mx, 32));
        float l = 0.f;
#pragma unroll
        for (int fp = 0; fp < 9; ++fp)
#pragma unroll
            for (int e = 0; e < 4; ++e) { const float p = __builtin_amdgcn_exp2f(sacc[fp][e] - mx); sacc[fp][e] = p; l += p; }
        sacc[9] = (f32x4){0.f, 0.f, 0.f, 0.f};
        l += __shfl_xor(l, 16); l += __shfl_xor(l, 32);
        l += __builtin_amdgcn_exp2f(sink2 - mx);
        const float inv = __builtin_amdgcn_rcpf(l);
        f32x4 oacc[4];
#pragma unroll
        for (int df = 0; df < 4; ++df) oacc[df] = (f32x4){0.f, 0.f, 0.f, 0.f};
#pragma unroll
        for (int s = 0; s < 5; ++s) {
            const u32x4 pw = (u32x4){cvt_pk_bf16(sacc[2 * s][0], sacc[2 * s][1]), cvt_pk_bf16(sacc[2 * s][2], sacc[2 * s][3]), cvt_pk_bf16(sacc[2 * s + 1][0], sacc[2 * s + 1][1]), cvt_pk_bf16(sacc[2 * s + 1][2], sacc[2 * s + 1][3])};
            const bf16x8 pb = __builtin_bit_cast(bf16x8, pw);
            s16x4 vt[2][4];
#pragma unroll
            for (int t = 0; t < 2; ++t) { const int f = (w + 2 * s + t) < 16 ? (w + 2 * s + t) : 15;
                const LAS unsigned char* vr = Vt + (16 * f + 4 * g + q4) * 128;
#pragma unroll
                for (int df = 0; df < 4; ++df) vt[t][df] = vtr(vr + 8 * ((4 * p4 + df) ^ vx)); }
#pragma unroll
            for (int df = 0; df < 4; ++df) oacc[df] = __builtin_amdgcn_mfma_f32_16x16x32_bf16(cat4(vt[0][df], vt[1][df]), pb, oacc[df], 0, 0, 0);
        }
        bf16_t* op = MIX + (size_t)qrow * D + 512 + hq * 64 + 16 * g;
        const u32x4 o0 = (u32x4){cvt_pk_bf16(oacc[0][0] * inv, oacc[0][1] * inv), cvt_pk_bf16(oacc[0][2] * inv, oacc[0][3] * inv), cvt_pk_bf16(oacc[1][0] * inv, oacc[1][1] * inv), cvt_pk_bf16(oacc[1][2] * inv, oacc[1][3] * inv)};
        const u32x4 o1 = (u32x4){cvt_pk_bf16(oacc[2][0] * inv, oacc[2][1] * inv), cvt_pk_bf16(oacc[2][2] * inv, oacc[2][3] * inv), cvt_pk_bf16(oacc[3][0] * inv, oacc[3][1] * inv), cvt_pk_bf16(oacc[3][2] * inv, oacc[3][3] * inv)};
        *(u32x4*)op = o0; *(u32x4*)(op + 8) = o1;
    }
    __syncthreads();
}

__device__ __forceinline__ void sgu_unit(const Frame& F, const bf16_t* P, bf16_t* MIX, const bf16_t* WSP, const float* gln, const float* bln, const float* bsp, int b, int n, unsigned char* g_ws_) {
    const int lane = F.lane, w = F.wave, gq = lane >> 4;
    LAS unsigned char* Vn = F.lds + RING_OFF;
    const int row0 = b * SEQ + n * 128;
    {
        const f32x4 g0 = *(const f32x4*)(gln + lane * 8), g1 = *(const f32x4*)(gln + lane * 8 + 4), b0 = *(const f32x4*)(bln + lane * 8), b1 = *(const f32x4*)(bln + lane * 8 + 4);
        u32x4 xv[16];
#pragma unroll
        for (int rr = 0; rr < 16; ++rr) xv[rr] = *(const u32x4*)(P + (size_t)(row0 + 16 * w + rr) * NIN + PC_V + lane * 8);
        float red[16];
#pragma unroll
        for (int rr = 0; rr < 16; ++rr) red[rr] = ((bflo(xv[rr][0]) + bfhi(xv[rr][0])) + (bflo(xv[rr][1]) + bfhi(xv[rr][1]))) + ((bflo(xv[rr][2]) + bfhi(xv[rr][2])) + (bflo(xv[rr][3]) + bfhi(xv[rr][3])));
#define SGU_TREDUCE(v) do { \
        _Pragma("unroll") for (int i = 0; i < 8; ++i) { const bool hi_ = lane & 1; const float keep = hi_ ? v[2 * i + 1] : v[2 * i], send = hi_ ? v[2 * i] : v[2 * i + 1]; v[i] = keep + __shfl_xor(send, 1); } \
        _Pragma("unroll") for (int i = 0; i < 4; ++i) { const bool hi_ = lane & 2; const float keep = hi_ ? v[2 * i + 1] : v[2 * i], send = hi_ ? v[2 * i] : v[2 * i + 1]; v[i] = keep + __shfl_xor(send, 2); } \
        _Pragma("unroll") for (int i = 0; i < 2; ++i) { const bool hi_ = lane & 4; const float keep = hi_ ? v[2 * i + 1] : v[2 * i], send = hi_ ? v[2 * i] : v[2 * i + 1]; v[i] = keep + __shfl_xor(send, 4); } \
        { const bool hi_ = lane & 8; const float keep = hi_ ? v[1] : v[0], send = hi_ ? v[0] : v[1]; v[0] = keep + __shfl_xor(send, 8); } \
        v[0] += __shfl_xor(v[0], 16); v[0] += __shfl_xor(v[0], 32); } while (0)
        SGU_TREDUCE(red);
        const float mu_l = red[0] * (1.0f / DA);
#pragma unroll
        for (int rr = 0; rr < 16; ++rr) { float q = 0.f; const float m_ = __shfl(mu_l, rr);
#pragma unroll
            for (int i = 0; i < 4; ++i) { const float d0 = bflo(xv[rr][i]) - m_, d1 = bfhi(xv[rr][i]) - m_; q += d0 * d0 + d1 * d1; }
            red[rr] = q; }
        SGU_TREDUCE(red);
#undef SGU_TREDUCE
        const float rs_l = __builtin_amdgcn_rsqf(red[0] * (1.0f / DA) + EPS);
        const int q = lane >> 4, c = lane & 15;
#pragma unroll
        for (int rr = 0; rr < 16; ++rr) {
            const float rs = __shfl(rs_l, rr), m_ = __shfl(mu_l, rr); const int s = 16 * w + rr;
            const unsigned o0 = cvt_pk_bf16((bflo(xv[rr][0]) - m_) * rs * g0[0] + b0[0], (bfhi(xv[rr][0]) - m_) * rs * g0[1] + b0[1]);
            const unsigned o1 = cvt_pk_bf16((bflo(xv[rr][1]) - m_) * rs * g0[2] + b0[2], (bfhi(xv[rr][1]) - m_) * rs * g0[3] + b0[3]);
            const unsigned o2 = cvt_pk_bf16((bflo(xv[rr][2]) - m_) * rs * g1[0] + b1[0], (bfhi(xv[rr][2]) - m_) * rs * g1[1] + b1[1]);
            const unsigned o3 = cvt_pk_bf16((bflo(xv[rr][3]) - m_) * rs * g1[2] + b1[2], (bfhi(xv[rr][3]) - m_) * rs * g1[3] + b1[3]);
            const int x = (s & 3) | (((s >> 3) & 1) << 2);
            *(LAS u32x4*)(Vn + q * 32768 + s * 256 + 16 * (c ^ (x >> 1))) = (x & 1) ? (u32x4){o2, o3, o0, o1} : (u32x4){o0, o1, o2, o3};
        }
    }
    __syncthreads(); STAMP(2);
    int lane_ = lane; asm volatile("" : "+v"(lane_));
    const int q4 = (lane_ & 15) >> 2, p4 = lane_ & 3;
    const int vx = q4 | ((gq & 1) << 2);
    bf16x8 wbn[4]; u32x4 uvn[4]; float biasn;
#define SGU_TB(G) (((G) < 2) ? w : 7 - w)
#define SGU_LOAD(G) do { const int t_ = 16 * SGU_TB(G) + (lane_ & 15); const bf16_t* wrow_ = WSP + (size_t)((G) * 128 + t_) * 128 + 8 * gq; const bf16_t* up_ = P + (size_t)(row0 + t_) * NIN + PC_U + (G) * 128 + 32 * gq; \
        _Pragma("unroll") for (int k = 0; k < 4; ++k) { wbn[k] = *(const bf16x8*)(wrow_ + 32 * k); uvn[k] = *(const u32x4*)(up_ + 8 * k); } biasn = bsp[(G) * 128 + t_]; } while (0)
    SGU_LOAD(0);
#pragma unroll
    for (int g = 0; g < NG; ++g) {
        f32x4 z[8];
#pragma unroll
        for (int cf = 0; cf < 8; ++cf) z[cf] = (f32x4){0.f, 0.f, 0.f, 0.f};
        bf16x8 wb[4]; u32x4 uv[4];
#pragma unroll
        for (int k = 0; k < 4; ++k) { wb[k] = wbn[k]; uv[k] = uvn[k]; }
        const float bias = biasn; const int tb = SGU_TB(g), t = 16 * tb + (lane_ & 15);
        if (g + 1 < NG) SGU_LOAD(g + 1);
#pragma unroll
        for (int ks = 0; ks < 4; ++ks) {
            if (ks <= (tb >> 1)) {
                s16x4 vt[2][8];
#pragma unroll
                for (int t2 = 0; t2 < 2; ++t2) { const LAS unsigned char* vr = Vn + g * 32768 + (32 * ks + 8 * gq + 4 * t2 + q4) * 256;
#pragma unroll
                    for (int cf = 0; cf < 8; ++cf) vt[t2][cf] = vtr(vr + 8 * ((8 * p4 + cf) ^ vx)); }
#pragma unroll
                for (int cf = 0; cf < 8; ++cf) z[cf] = __builtin_amdgcn_mfma_f32_16x16x32_bf16(cat4(vt[0][cf], vt[1][cf]), wb[ks], z[cf], 0, 0, 0);
            }
        }
        bf16_t* op = MIX + (size_t)(row0 + t) * D + g * 128 + 32 * gq;
#pragma unroll
        for (int k = 0; k < 4; ++k) {
            float uf[8]; unpack8(uv[k], uf);
            const f32x4 za = z[2 * k] + bias, zb = z[2 * k + 1] + bias;
            *(u32x4*)(op + 8 * k) = (u32x4){cvt_pk_bf16(uf[0] * za[0], uf[1] * za[1]), cvt_pk_bf16(uf[2] * za[2], uf[3] * za[3]), cvt_pk_bf16(uf[4] * zb[0], uf[5] * zb[1]), cvt_pk_bf16(uf[6] * zb[2], uf[7] * zb[3])};
        }
    }
#undef SGU_LOAD
#undef SGU_TB
    STAMP(3);
    __syncthreads();
}

__device__ __forceinline__ void mixer_phase(const Frame& F, const Args& a, const WsPtrs& w) {
    unsigned char* g_ws_ = a.ws; (void)g_ws_; STAMP(0);
    constexpr int NATT = BATCH * NCH * NKVH, NSGU = BATCH * NCH;
    {
        KVRaw raw;
        int u = F.vcu;
        if (u < NATT) attn_load_kv(raw, F, w.P, u >> 5, (u >> 1) & 15, u & 1);
        for (; u < NATT; u += F.G) {
            const int un = u + F.G; const bool has_next = un < NATT;
            attn_unit(F, w.P, w.MIX, a.in[14], a.in[15], a.in[16], u >> 5, (u >> 1) & 15, u & 1, raw, has_next, un >> 5, (un >> 1) & 15, un & 1);
        }
    }
    STAMP(1);
    for (int u = F.vcu; u < NSGU; u += F.G) sgu_unit(F, w.P, w.MIX, w.WSP, a.in[10], a.in[11], a.in[13], u >> 4, u & 15, a.ws);
    STAMP(4);
}

__global__ void __launch_bounds__(NWAVES * 64, 2) mega_fwd(Args args) {
    extern __shared__ __attribute__((aligned(16))) unsigned char lds[];
    Frame F;
    F.lds = (LAS unsigned char*)lds;
    F.MISC = (volatile LAS unsigned*)(F.lds + MISC_OFF);
    F.tid = threadIdx.x; F.lane = F.tid & 63; F.wave = __builtin_amdgcn_readfirstlane(F.tid >> 6);
    F.G = gridDim.x; { const int bx = blockIdx.x; F.vcu = (F.G % 8 == 0) ? (bx % 8) * (F.G / 8) + bx / 8 : bx; }
    unsigned char* ws = args.ws;
    WsPtrs w;
    w.mods = (float*)(ws + WS_MODS); w.cb1 = (float*)(ws + WS_CB1); w.cb2 = (float*)(ws + WS_CB2); w.cb3 = (float*)(ws + WS_CB3);
    w.ss1 = (float*)(ws + WS_SS1); w.ss2 = (float*)(ws + WS_SS2); w.ss3 = (float*)(ws + WS_SS3);
    w.WGU1 = (bf16_t*)(ws + WS_WGU1); w.WD1 = (bf16_t*)(ws + WS_WD1); w.WIN = (bf16_t*)(ws + WS_WIN); w.WA = (bf16_t*)(ws + WS_WA); w.WB = (bf16_t*)(ws + WS_WB);
    w.WO = (bf16_t*)(ws + WS_WO); w.WGU2 = (bf16_t*)(ws + WS_WGU2); w.WD2 = (bf16_t*)(ws + WS_WD2); w.WSP = (bf16_t*)(ws + WS_WSP);
    w.H16 = (_Float16*)(ws + WS_H16); w.XN = (bf16_t*)(ws + WS_XN); w.MIX = (bf16_t*)(ws + WS_MIX); w.MERGED = (bf16_t*)(ws + WS_MERGED); w.ACT = (bf16_t*)(ws + WS_ACT); w.P = (bf16_t*)(ws + WS_P);
    for (int u = F.tid; u < (LDS_BYTES - LDSCTL_OFF) / 4; u += NWAVES * 64) ((LAS unsigned*)(F.lds + LDSCTL_OFF))[u] = 0u;
    __syncthreads();
    XcdBarrier bar = xcd_barrier_post((unsigned*)(ws + WS_CTL) + CW_BAR + args.li * XCD_BAR_WORDS, F.MISC + 8);
    const int lo = args.ph_lo, hi = args.ph_hi;
#define IN(k) (lo <= (k) && (k) < hi)
#ifdef PROBE_WORK
#define SEAM(k) do { if ((k) == PROBE_LO) epi_ticks = __builtin_amdgcn_s_memrealtime() - pr_t0; if (IN(k) && IN((k) + 1)) xcd_barrier(bar); } while (0)
#else
#define SEAM(k) do { if (IN(k) && IN((k) + 1)) xcd_barrier(bar); } while (0)
#endif
    const int cid = (int)blockIdx.x;
    float* out = args.out;
    unsigned long long epi_ticks = 0;
#ifdef PROBE_LO
    unsigned long long pr_t0 = 0, pr_t1 = 0;
#ifdef PROBE_CLOCK
    unsigned long long pr_c0 = 0, pr_c1 = 0;
#define PR_BEGIN(k) do { if ((k) == PROBE_LO) { pr_t0 = __builtin_amdgcn_s_memrealtime(); pr_c0 = __builtin_amdgcn_s_memtime(); } } while (0)
#else
#define PR_BEGIN(k) do { if ((k) == PROBE_LO) { pr_t0 = __builtin_amdgcn_s_memrealtime(); epi_ticks = 0; } } while (0)
#endif
#ifdef PROBE_CLOCK
#define PR_END(k) do { if ((k) == PROBE_HI) { pr_c1 = __builtin_amdgcn_s_memtime(); pr_t1 = __builtin_amdgcn_s_memrealtime(); pr_t1 = pr_t0 + (unsigned long long)((double)(pr_c1 - pr_c0) / (double)(pr_t1 - pr_t0) * 10000.0); } } while (0)
#elif defined(PROBE_RED)
#define PR_END(k) do { if ((k) == PROBE_HI && F.tid == 0) { atomicMax((unsigned*)(ws + WS_CTL) + 64, (unsigned)epi_ticks); atomicAdd((unsigned*)(ws + WS_CTL) + 65, (unsigned)epi_ticks); } } while (0)
#elif defined(PROBE_EPI)
#define PR_END(k) do { if ((k) == PROBE_HI) { pr_t1 = pr_t0 + epi_ticks; } } while (0)
#else
#define PR_END(k) do { if ((k) == PROBE_HI) pr_t1 = __builtin_amdgcn_s_memrealtime(); } while (0)
#endif
#else
#define PR_BEGIN(k) do {} while (0)
#define PR_END(k) do {} while (0)
#endif

    if (IN(0)) { PR_BEGIN(0); p0_prologue(F, args, w); SEAM(0); PR_END(0); }
    if (IN(1)) { PR_BEGIN(1); p1_phase(F, args, w); SEAM(1); PR_END(1); }
    if (IN(2)) { PR_BEGIN(2);
        pg8::Gemm g{w.XN, w.XN, w.WGU1, w.WGU1, D, D, D}; pg8::StaticOrder S; S.init(M, NGU, F.G, cid);
        EpiGU<true> E{w.ACT, nullptr, nullptr};
        pg8::gemm_phase(F.lds + RING_OFF, g, S, E, epi_ticks); SEAM(2); PR_END(2);
    }
    if (IN(3)) { PR_BEGIN(3);
        pg8::Gemm g{w.ACT, w.ACT, w.WD1, w.WD1, FF, FF, FF}; pg8::StaticOrder S; S.init(M, D, F.G, cid, 1, 1);
        EpiRes<true, false, true> E{args.in[0], w.H16, w.mods + 2 * D, args.in[8], w.mods + 4 * D, w.XN, w.ss2, (LAS float*)(F.lds + RED_OFF), 0.5f};
#ifdef PROBE_SKEW
        if (blockIdx.x & 1) { const unsigned long long t0_ = __builtin_amdgcn_s_memrealtime(); while (__builtin_amdgcn_s_memrealtime() - t0_ < (unsigned long long)(PROBE_SKEW * 100)) __builtin_amdgcn_s_sleep(8); }
#endif
        pg8::gemm_phase(F.lds + RING_OFF, g, S, E, epi_ticks); SEAM(3); PR_END(3);
    }
    if (IN(4)) { PR_BEGIN(4);
        pg8::Gemm g{w.XN, w.XN, w.WIN, w.WIN, D, D, D}; pg8::StaticOrder S; S.init(M, NIN, F.G, cid);
        EpiWin E{w.P, w.ss2, w.cb2};
        pg8::gemm_phase(F.lds + RING_OFF, g, S, E, epi_ticks);
        SEAM(4); PR_END(4);
    }
    if (IN(5)) { PR_BEGIN(5);
        mixer_phase(F, args, w);
        SEAM(5); PR_END(5);
#ifdef PROBE_STAMPS
        if (blockIdx.x == 0 && F.tid == 0) { const unsigned long long* st_ = (const unsigned long long*)(ws + WS_CTL) + 40; pr_t0 = st_[PROBE_SA]; pr_t1 = st_[PROBE_SB]; }
#endif
    }
    if (IN(6)) { PR_BEGIN(6);
        pg8::Gemm g{w.MIX, w.MIX + 512, w.WA, w.WB, D, DA, DA}; pg8::StaticOrder S; S.init(M, D, F.G, cid, 2);
        EpiBranch E{w.P, w.MERGED};
        pg8::gemm_phase(F.lds + RING_OFF, g, S, E, epi_ticks); SEAM(6); PR_END(6);
    }
    if (IN(7)) { PR_BEGIN(7);
        pg8::Gemm g{w.MERGED, w.MERGED, w.WO, w.WO, D, D, D}; pg8::StaticOrder S; S.init(M, D, F.G, cid);
        EpiRes<true, true, true> E{w.H16, w.H16, w.mods + 5 * D, args.in[20], w.mods + 7 * D, w.XN, w.ss3, (LAS float*)(F.lds + RED_OFF), 1.0f};
        pg8::gemm_phase(F.lds + RING_OFF, g, S, E, epi_ticks); SEAM(7); PR_END(7);
    }
    if (IN(8)) { PR_BEGIN(8);
        pg8::Gemm g{w.XN, w.XN, w.WGU2, w.WGU2, D, D, D}; pg8::StaticOrder S; S.init(M, NGU, F.G, cid);
        EpiGU<false> E{w.ACT, w.ss3, w.cb3};
        pg8::gemm_phase(F.lds + RING_OFF, g, S, E, epi_ticks); SEAM(8); PR_END(8);
    }
    if (IN(9)) { PR_BEGIN(9);
        pg8::Gemm g{w.ACT, w.ACT, w.WD2, w.WD2, FF, FF, FF}; pg8::StaticOrder S; S.init(M, D, F.G, cid, 1, 1);
        EpiRes<false, true, false> E{w.H16, out, w.mods + 8 * D, nullptr, nullptr, nullptr, nullptr, nullptr, 0.5f};
        pg8::gemm_phase(F.lds + RING_OFF, g, S, E, epi_ticks);
#ifdef PROBE_LO
        xcd_barrier(bar); PR_END(9);
#ifdef PROBE_RED
        xcd_barrier(bar);
        if (blockIdx.x == 0 && F.tid == 0) { const unsigned mx_ = __hip_atomic_load((unsigned*)(ws + WS_CTL) + 64, RLX_AGENT), sm_ = __hip_atomic_load((unsigned*)(ws + WS_CTL) + 65, RLX_AGENT);
            pr_t0 = 0; pr_t1 = (PROBE_RED == 1) ? mx_ : sm_ / gridDim.x; }
#endif
        if (blockIdx.x == 0 && F.tid == 0) out[0] += PROBE_Q * floorf(((float)(pr_t1 - pr_t0) * 0.01f + PROBE_OFF) * (1.0f / PROBE_Q));
#endif
    }
#undef IN
#undef SEAM
}

extern "C" void kernel_launch(void* const* d_in, const int* in_sizes, int n_in, void* d_out, int out_size, void* d_ws, size_t ws_size, hipStream_t stream) {
    static int grid = 0;
    if (grid == 0) {
        if (n_in != 24 || in_sizes[0] != M * D || out_size != M * D || ws_size < WS_END) {
            fprintf(stderr, "kernel_launch: unexpected shapes (n_in %d, in0 %d, out %d, ws %zu < %zu); nothing launched\n", n_in, n_in > 0 ? in_sizes[0] : -1, out_size, ws_size, (size_t)WS_END); grid = -1; return; }
        int dev = 0, cus = 0, per_cu = 0;
        if (hipGetDevice(&dev) != hipSuccess || hipDeviceGetAttribute(&cus, hipDeviceAttributeMultiprocessorCount, dev) != hipSuccess) { fprintf(stderr, "kernel_launch: device query failed\n"); grid = -1; return; }
        if (hipFuncSetAttribute((const void*)mega_fwd, hipFuncAttributeMaxDynamicSharedMemorySize, LDS_BYTES) != hipSuccess) { fprintf(stderr, "kernel_launch: hipFuncSetAttribute failed\n"); grid = -1; return; }
        if (hipOccupancyMaxActiveBlocksPerMultiprocessor(&per_cu, (const void*)mega_fwd, NWAVES * 64, LDS_BYTES) != hipSuccess || per_cu < 1) {
            fprintf(stderr, "kernel_launch: occupancy query reports %d workgroups per CU; nothing launched\n", per_cu); (void)hipGetLastError(); grid = -1; return; }
        grid = cus;
        fprintf(stderr, "kernel_launch: grid %d (occupancy query: %d per CU)\n", grid, per_cu);
    }
    if (grid < 0) return;
    (void)hipMemsetAsync((char*)d_ws + WS_CTL, 0, CTL_BYTES, stream);
    Args a; memset(&a, 0, sizeof a);
    for (int i = 0; i < 24; ++i) a.in[i] = (const float*)d_in[i];
    a.out = (float*)d_out; a.ws = (unsigned char*)d_ws;
#if N_LAUNCHES == 1
    a.ph_lo = 0; a.ph_hi = 10; a.li = 0;
    hipLaunchKernelGGL(mega_fwd, dim3(grid), dim3(NWAVES * 64), LDS_BYTES, stream, a);
#else
    a.ph_lo = 0; a.ph_hi = 5; a.li = 0;
    hipLaunchKernelGGL(mega_fwd, dim3(grid), dim3(NWAVES * 64), LDS_BYTES, stream, a);
    {
        unsigned char* ws = (unsigned char*)d_ws; const float* const* in = (const float* const*)d_in;
        bf16_t* P = (bf16_t*)(ws + WS_P); bf16_t* MIX = (bf16_t*)(ws + WS_MIX); bf16_t* VN = (bf16_t*)(ws + WS_MERGED); bf16_t* WSP = (bf16_t*)(ws + WS_WSP);
        k_vln<<<M / 4, 256, 0, stream>>>(P, in[10], in[11], VN);
        k_sgu<<<M * 2, 256, 0, stream>>>(P, VN, WSP, in[13], MIX);
        k_attn<<<BATCH * NCH * NQH, 128, 0, stream>>>(P, in[14], in[15], in[16], MIX);
    }
    a.ph_lo = 6; a.ph_hi = 10; a.li = 1;
    hipLaunchKernelGGL(mega_fwd, dim3(grid), dim3(NWAVES * 64), LDS_BYTES, stream, a);
#endif
}
```
